# Optimizing an MI355X kernel written in HIP

```python
import jax, jax.numpy as jnp
from jax import lax
import numpy as np

D_MODEL = 1024
BATCH = 2
SEQ = 8192
DEPTH = 2

CTX_LEN = 256
GRID_W = 64
HEAD_DIM = 64
ROPE_BASE = 10000.0
ATT_HEADS = 8
ATT_KV_HEADS = 2
ATT_GROUP = ATT_HEADS // ATT_KV_HEADS
ATT_WIDTH = ATT_HEADS * HEAD_DIM
KV_WIDTH = ATT_KV_HEADS * HEAD_DIM
WINDOW = 128
BLOCK = 128
ATT_SCALE = HEAD_DIM ** -0.5
NEG_INF = -1e30
FNET_GROUPS = 4
FNET_WIDTH = FNET_GROUPS * HEAD_DIM
GLA_HEADS = 4
GLA_WIDTH = GLA_HEADS * HEAD_DIM
GLA_GATE_RANK = 16
GLA_TAU = 16.0
GLA_CHUNK = 64
GLA_SCALE = HEAD_DIM ** -0.5
MIX_WIDTH = ATT_WIDTH + FNET_WIDTH + GLA_WIDTH
_O1 = ATT_WIDTH
_O2 = _O1 + KV_WIDTH
_O3 = _O2 + KV_WIDTH
_O4 = _O3 + FNET_WIDTH
_O5 = _O4 + GLA_WIDTH
_O6 = _O5 + GLA_WIDTH
_O7 = _O6 + GLA_WIDTH
_O8 = _O7 + GLA_WIDTH
IN_WIDTH = _O8 + 2 * GLA_GATE_RANK
IN_SPLITS = (_O1, _O2, _O3, _O4, _O5, _O6, _O7, _O8)
FFN_HIDDEN = ((8 * D_MODEL // 3 + 255) // 256) * 256

kernel_name = "hybrid_prefix_dit_gqa_fnet_gla"


def rms_norm(x, g, eps=1e-6):
    xf = x.astype(jnp.float32)
    y = xf * lax.rsqrt(jnp.mean(xf * xf, axis=-1, keepdims=True) + eps)
    return (y * g.astype(jnp.float32)).astype(x.dtype)


def split_heads(t, nh):
    return t.reshape(t.shape[0], t.shape[1], nh, HEAD_DIM)


def axial_rope_tables(n):
    rows = n // GRID_W
    row = jnp.repeat(jnp.arange(rows, dtype=jnp.float32), GRID_W)
    col = jnp.tile(jnp.arange(GRID_W, dtype=jnp.float32), rows)
    axis_dim = HEAD_DIM // 2
    inv_freq = ROPE_BASE ** (-jnp.arange(0, axis_dim, 2, dtype=jnp.float32) / axis_dim)
    ang_r = row[:, None] * inv_freq[None, :]
    ang_c = col[:, None] * inv_freq[None, :]
    return (jnp.cos(ang_r), jnp.sin(ang_r), jnp.cos(ang_c), jnp.sin(ang_c))


def _rotate(x, cos, sin):
    m = x.shape[-1] // 2
    x1, x2 = x[..., :m], x[..., m:]
    c = cos[:, None, :]
    s = sin[:, None, :]
    return jnp.concatenate([x1 * c - x2 * s, x2 * c + x1 * s], axis=-1)


def apply_axial_rope(x, rope):
    cos_r, sin_r, cos_c, sin_c = rope
    h = HEAD_DIM // 2
    xf = x.astype(jnp.float32)
    y = jnp.concatenate([_rotate(xf[..., :h], cos_r, sin_r), _rotate(xf[..., h:], cos_c, sin_c)], axis=-1)
    return y.astype(x.dtype)


def context_attention(qc, kc, vc, sink):
    B, L = qc.shape[0], qc.shape[1]
    q = qc.reshape(B, L, ATT_KV_HEADS, ATT_GROUP, HEAD_DIM)
    s = jnp.einsum('bqkgd,bskd->bkgqs', q, kc).astype(jnp.float32) * ATT_SCALE
    sk = sink.astype(jnp.float32).reshape(1, ATT_KV_HEADS, ATT_GROUP, 1, 1)
    m = jnp.maximum(s.max(-1, keepdims=True), sk)
    p = jnp.exp(s - m)
    p = p / (p.sum(-1, keepdims=True) + jnp.exp(sk - m))
    o = jnp.einsum('bkgqs,bskd->bqkgd', p.astype(vc.dtype), vc)
    return o.reshape(B, L, ATT_WIDTH)


def window_attention(q, k, v, kc, vc, sink):
    B, n = q.shape[0], q.shape[1]
    nb = n // BLOCK
    nbr = WINDOW // BLOCK
    span = BLOCK + 2 * WINDOW
    qb = q.reshape(B, nb, BLOCK, ATT_KV_HEADS, ATT_GROUP, HEAD_DIM)
    pad = ((0, 0), (WINDOW, WINDOW), (0, 0), (0, 0))
    kp = jnp.pad(k, pad).reshape(B, nb + 2 * nbr, BLOCK, ATT_KV_HEADS, HEAD_DIM)
    vp = jnp.pad(v, pad).reshape(B, nb + 2 * nbr, BLOCK, ATT_KV_HEADS, HEAD_DIM)
    kb = jnp.concatenate([kp[:, i:i + nb] for i in range(2 * nbr + 1)], axis=2)
    vb = jnp.concatenate([vp[:, i:i + nb] for i in range(2 * nbr + 1)], axis=2)
    qi = jnp.arange(BLOCK)[:, None]
    kj = jnp.arange(span)[None, :]
    band = jnp.abs(qi + WINDOW - kj) <= WINDOW
    kpos = jnp.arange(nb)[:, None] * BLOCK - WINDOW + jnp.arange(span)[None, :]
    valid = band[None] & ((kpos >= 0) & (kpos < n))[:, None, :]
    s_loc = jnp.einsum('bnqkgd,bnskd->bnkgqs', qb, kb).astype(jnp.float32) * ATT_SCALE
    s_loc = jnp.where(valid[None, :, None, None], s_loc, NEG_INF)
    s_ctx = jnp.einsum('bnqkgd,bskd->bnkgqs', qb, kc).astype(jnp.float32) * ATT_SCALE
    sk = sink.astype(jnp.float32).reshape(1, 1, ATT_KV_HEADS, ATT_GROUP, 1, 1)
    m = jnp.maximum(jnp.maximum(s_loc.max(-1, keepdims=True), s_ctx.max(-1, keepdims=True)), sk)
    p_loc = jnp.exp(s_loc - m)
    p_ctx = jnp.exp(s_ctx - m)
    inv = 1.0 / (p_loc.sum(-1, keepdims=True) + p_ctx.sum(-1, keepdims=True) + jnp.exp(sk - m))
    o = (jnp.einsum('bnkgqs,bnskd->bnqkgd', (p_loc * inv).astype(v.dtype), vb)
         + jnp.einsum('bnkgqs,bskd->bnqkgd', (p_ctx * inv).astype(vc.dtype), vc))
    return o.reshape(B, n, ATT_WIDTH)


def fourier_mix(u, w_f):
    B, n = u.shape[0], u.shape[1]
    ug = u.reshape(B, n, FNET_GROUPS, HEAD_DIM).astype(jnp.float32)
    f = jnp.fft.fft2(ug, axes=(1, 3), norm='ortho').real
    y = jnp.einsum('bngc,gce->bnge', f.astype(u.dtype), w_f)
    return y.reshape(B, n, FNET_WIDTH)


def gla_chunked(q, k, v, log_a, s0):
    B, T, H, dk = q.shape
    dv = v.shape[-1]
    nc = T // GLA_CHUNK
    rs = lambda t: t.reshape(B, nc, GLA_CHUNK, H, t.shape[-1]).astype(jnp.float32)
    qc, kc, vc = rs(q), rs(k), rs(v)
    bcum = jnp.cumsum(rs(log_a), axis=2)
    btot = bcum[:, :, -1]
    q_in = qc * jnp.exp(bcum)
    k_in = kc * jnp.exp(-bcum)
    k_out = kc * jnp.exp(btot[:, :, None] - bcum)
    lower = jnp.tril(jnp.ones((GLA_CHUNK, GLA_CHUNK), dtype=bool))
    att = jnp.einsum('bnthd,bnshd->bnhts', q_in, k_in)
    att = jnp.where(lower, att, 0.0)
    o_intra = jnp.einsum('bnhts,bnshe->bnthe', att, vc)
    u = jnp.einsum('bnshd,bnshe->bnhde', k_out, vc)
    decay = jnp.exp(btot)

    def step(S, inp):
        d, uu = inp
        return d[..., None] * S + uu, S

    s_final, s_starts = lax.scan(step, s0.astype(jnp.float32),
                                 (jnp.moveaxis(decay, 1, 0), jnp.moveaxis(u, 1, 0)))
    s_starts = jnp.moveaxis(s_starts, 0, 1)
    o_inter = jnp.einsum('bnthd,bnhde->bnthe', q_in, s_starts)
    o = (o_intra + o_inter).reshape(B, T, H, dv)
    return o, s_final


def gla_gates(z_lr, w_gate, b_gate):
    z = (z_lr @ w_gate + b_gate).astype(jnp.float32)
    la = jax.nn.log_sigmoid(z) / GLA_TAU
    return la.reshape(la.shape[0], la.shape[1], GLA_HEADS, HEAD_DIM)


def gla_mixer(lat, ctxp, wgf, bgf, wgb, bgb, norm_g, need_ctx):
    def prep(q, k, v, r, z):
        q = split_heads(q, GLA_HEADS) * GLA_SCALE
        k = split_heads(k, GLA_HEADS)
        v = split_heads(v, GLA_HEADS)
        laf = gla_gates(z[..., :GLA_GATE_RANK], wgf, bgf)
        lab = gla_gates(z[..., GLA_GATE_RANK:], wgb, bgb)
        return q, k, v, laf, lab

    ql, kl, vl, lfl, lbl = prep(*lat)
    qc, kc, vc, lfc, lbc = prep(*ctxp)
    B = ql.shape[0]
    s0 = jnp.zeros((B, GLA_HEADS, HEAD_DIM, HEAD_DIM), jnp.float32)
    flip = lambda t: t[:, ::-1]
    o_cf, s_cf = gla_chunked(qc, kc, vc, lfc, s0)
    o_cb, s_cb = gla_chunked(flip(qc), flip(kc), flip(vc), flip(lbc), s0)
    o_lf, _ = gla_chunked(ql, kl, vl, lfl, s_cf)
    o_lb, _ = gla_chunked(flip(ql), flip(kl), flip(vl), flip(lbl), s_cb)

    def finish(o, r):
        y = rms_norm(o, norm_g).reshape(o.shape[0], o.shape[1], GLA_WIDTH).astype(r.dtype)
        return y * jax.nn.silu(r)

    y_l = finish(o_lf + flip(o_lb), lat[3])
    y_c = finish(o_cf + flip(o_cb), ctxp[3]) if need_ctx else None
    return y_l, y_c


def token_mixers(h, hc, w_in, q_g, k_g, sink, w_f, wgf, bgf, wgb, bgb, gla_g, rope, need_ctx):
    aq, ak, av, fu, gq, gk, gv, gr, gz = jnp.split(h @ w_in, IN_SPLITS, axis=-1)
    caq, cak, cav, cfu, cgq, cgk, cgv, cgr, cgz = jnp.split(hc @ w_in, IN_SPLITS, axis=-1)
    q = apply_axial_rope(rms_norm(split_heads(aq, ATT_HEADS), q_g), rope)
    k = apply_axial_rope(rms_norm(split_heads(ak, ATT_KV_HEADS), k_g), rope)
    v = split_heads(av, ATT_KV_HEADS)
    kc = rms_norm(split_heads(cak, ATT_KV_HEADS), k_g)
    vc = split_heads(cav, ATT_KV_HEADS)
    att = window_attention(q, k, v, kc, vc, sink)
    four = fourier_mix(fu, w_f)
    gla, gla_c = gla_mixer((gq, gk, gv, gr, gz), (cgq, cgk, cgv, cgr, cgz), wgf, bgf, wgb, bgb, gla_g, need_ctx)
    mix = jnp.concatenate([att, four, gla], axis=-1)
    mix_c = None
    if need_ctx:
        qc = rms_norm(split_heads(caq, ATT_HEADS), q_g)
        att_c = context_attention(qc, kc, vc, sink)
        four_c = fourier_mix(cfu, w_f)
        mix_c = jnp.concatenate([att_c, four_c, gla_c], axis=-1)
    return mix, mix_c


def swiglu(h, w_ffn_in, w_ffn_out):
    gate, up = jnp.split(h @ w_ffn_in, 2, axis=-1)
    return (jax.nn.silu(gate) * up) @ w_ffn_out


def setup_inputs(seed: int = 0) -> dict:
    key = jax.random.key(seed)
    ks = jax.random.split(key, 24)
    nrm = lambda k, shape, scale: jax.random.normal(k, shape, jnp.float32) * scale
    return {
        'x': nrm(ks[0], (BATCH, SEQ, D_MODEL), 1.0),
        'c': nrm(ks[1], (BATCH, D_MODEL), 1.0),
        'ctx': nrm(ks[2], (BATCH, CTX_LEN, D_MODEL), 1.0),
        'c_ctx': nrm(ks[3], (D_MODEL,), 1.0),
        'w_mod': nrm(ks[4], (DEPTH, D_MODEL, 6 * D_MODEL), 0.5 * D_MODEL ** -0.5),
        'b_mod': nrm(ks[5], (DEPTH, 6 * D_MODEL), 0.02),
        'g_norm1': 1.0 + nrm(ks[6], (DEPTH, D_MODEL), 0.02),
        'w_in': nrm(ks[7], (DEPTH, D_MODEL, IN_WIDTH), D_MODEL ** -0.5),
        'q_norm_g': 1.0 + nrm(ks[8], (DEPTH, HEAD_DIM), 0.02),
        'k_norm_g': 1.0 + nrm(ks[9], (DEPTH, HEAD_DIM), 0.02),
        'attn_sink': nrm(ks[10], (DEPTH, ATT_HEADS), 0.5),
        'w_fourier': nrm(ks[11], (DEPTH, FNET_GROUPS, HEAD_DIM, HEAD_DIM), HEAD_DIM ** -0.5),
        'gla_w_gate_f': nrm(ks[12], (DEPTH, GLA_GATE_RANK, GLA_WIDTH), GLA_GATE_RANK ** -0.5),
        'gla_b_gate_f': nrm(ks[13], (DEPTH, GLA_WIDTH), 0.1),
        'gla_w_gate_b': nrm(ks[14], (DEPTH, GLA_GATE_RANK, GLA_WIDTH), GLA_GATE_RANK ** -0.5),
        'gla_b_gate_b': nrm(ks[15], (DEPTH, GLA_WIDTH), 0.1),
        'gla_norm_g': 1.0 + nrm(ks[16], (DEPTH, HEAD_DIM), 0.02),
        'w_out': nrm(ks[17], (DEPTH, MIX_WIDTH, D_MODEL), MIX_WIDTH ** -0.5),
        'g_norm2': 1.0 + nrm(ks[18], (DEPTH, D_MODEL), 0.02),
        'w_ffn_in': nrm(ks[19], (DEPTH, D_MODEL, 2 * FFN_HIDDEN), D_MODEL ** -0.5),
        'w_ffn_out': nrm(ks[20], (DEPTH, FFN_HIDDEN, D_MODEL), FFN_HIDDEN ** -0.5),
    }


def reference(x, c, ctx, c_ctx, w_mod, b_mod, g_norm1, w_in, q_norm_g, k_norm_g, attn_sink, w_fourier,
              gla_w_gate_f, gla_b_gate_f, gla_w_gate_b, gla_b_gate_b, gla_norm_g, w_out, g_norm2,
              w_ffn_in, w_ffn_out):
    n = x.shape[1]
    rope = axial_rope_tables(n)
    xc = ctx
    for l in range(DEPTH):
        need_ctx = l < DEPTH - 1
        mod_l = (jax.nn.silu(c) @ w_mod[l] + b_mod[l])[:, None, :]
        mod_c = (jax.nn.silu(c_ctx) @ w_mod[l] + b_mod[l])[None, None, :]
        sh1, sc1, gt1, sh2, sc2, gt2 = jnp.split(mod_l, 6, axis=-1)
        csh1, csc1, cgt1, csh2, csc2, cgt2 = jnp.split(mod_c, 6, axis=-1)
        h = rms_norm(x, g_norm1[l]) * (1.0 + sc1) + sh1
        hc = rms_norm(xc, g_norm1[l]) * (1.0 + csc1) + csh1
        mix, mix_c = token_mixers(h, hc, w_in[l], q_norm_g[l], k_norm_g[l], attn_sink[l], w_fourier[l],
                                  gla_w_gate_f[l], gla_b_gate_f[l], gla_w_gate_b[l], gla_b_gate_b[l],
                                  gla_norm_g[l], rope, need_ctx)
        x = x + gt1 * (mix @ w_out[l])
        h2 = rms_norm(x, g_norm2[l]) * (1.0 + sc2) + sh2
        x = x + gt2 * swiglu(h2, w_ffn_in[l], w_ffn_out[l])
        if need_ctx:
            xc = xc + cgt1 * (mix_c @ w_out[l])
            hc2 = rms_norm(xc, g_norm2[l]) * (1.0 + csc2) + csh2
            xc = xc + cgt2 * swiglu(hc2, w_ffn_in[l], w_ffn_out[l])
    return x
```

```cpp
#include <hip/hip_runtime.h>
#include <hip/hip_cooperative_groups.h>
#include <cstdio>
#include <cstdint>
namespace cg = cooperative_groups;

typedef unsigned short bf16_t;
typedef short bf16x8 __attribute__((ext_vector_type(8)));
typedef short bf16x4 __attribute__((ext_vector_type(4)));
typedef float f32x4 __attribute__((ext_vector_type(4)));
typedef unsigned u32x4 __attribute__((ext_vector_type(4)));
typedef unsigned u32x2 __attribute__((ext_vector_type(2)));

#define DEVI __device__ __forceinline__
#ifndef N_LAUNCH_SPLIT
#define N_LAUNCH_SPLIT 0
#endif

constexpr int NT = 512;
constexpr int DM = 1024, SEQ = 8192, CTXL = 256;
constexpr int TOKL = 16384, TOKC = 512, TOK = 16896;
constexpr int INW = 2080, INWP = 2304, FFH = 2816;
constexpr int NCI = 132;
constexpr int LDS_BYTES = 147456;

constexpr size_t SZ_WIN = (size_t)INWP * DM * 2, SZ_WOUT = (size_t)DM * DM * 2, SZ_WFI = (size_t)2 * FFH * DM * 2, SZ_WFO = (size_t)DM * FFH * 2;
constexpr size_t WS_WIN = 0;
constexpr size_t WS_WOUT = WS_WIN + 2 * SZ_WIN;
constexpr size_t WS_WFI = WS_WOUT + 2 * SZ_WOUT;
constexpr size_t WS_WFO = WS_WFI + 2 * SZ_WFI;
constexpr size_t WS_MOD = WS_WFO + 2 * SZ_WFO;
constexpr size_t WS_ROPE = WS_MOD + 2 * 3 * 6144 * 4;
constexpr size_t WS_D128 = WS_ROPE + 2 * 128 * 16 * 4;
constexpr size_t WS_T64 = WS_D128 + 256 * 128 * 2;
constexpr size_t WS_MMT = WS_T64 + 128 * 128 * 2;
constexpr size_t WS_XC = WS_MMT + 2 * 4 * 64 * 128 * 2;
constexpr size_t WS_DEC = WS_XC + (size_t)TOKC * DM * 4;
constexpr size_t WS_H = WS_DEC + (size_t)2 * 2 * NCI * 4 * 64 * 4;
constexpr size_t WS_MIX = WS_H + (size_t)TOK * DM * 2;
constexpr size_t WS_P = WS_MIX + (size_t)TOK * DM * 2;
constexpr size_t WS_VTL = WS_P + (size_t)TOK * INWP * 2;
constexpr size_t WS_VTC = WS_VTL + (size_t)2 * 2 * 64 * SEQ * 2;
constexpr size_t WS_YP = WS_VTC + (size_t)2 * 2 * 64 * CTXL * 2;
constexpr size_t WS_UT = WS_YP + (size_t)2 * 4 * 128 * 2 * 64 * 64 * 2;
constexpr size_t WS_END = WS_UT + (size_t)2 * 2 * NCI * 4 * 4096 * 2;
constexpr size_t WS_BAR = WS_END;
constexpr size_t WS_PART = WS_BAR + 16384;
constexpr size_t WS_YPC = WS_PART + (size_t)4 * TOKC * DM * 4;
constexpr size_t WS_LA = WS_YPC + (size_t)2 * 4 * 4 * 2 * 64 * 64 * 2;
constexpr size_t WS_TOTAL = WS_LA + (size_t)2 * NCI * 4 * 2 * 64 * 64 * 2;
constexpr size_t WS_HID = WS_P;
static_assert(WS_HID + (size_t)TOK * FFH * 2 <= WS_UT, "HID overlay");
static_assert(WS_TOTAL <= 268435456ull, "workspace");

struct Params {
    const float *x, *c, *ctx, *c_ctx, *w_mod, *b_mod, *g1, *w_in, *qg, *kg, *sink, *wf, *wgf, *bgf, *wgb, *bgb, *glag, *w_out, *g2, *w_fi, *w_fo;
    float* out; unsigned char* ws;
    int ph_lo, ph_hi;
};

DEVI int tidx() { int t = threadIdx.x; asm volatile("" : "+v"(t)); return t; }
typedef __bf16 bf16v2 __attribute__((ext_vector_type(2)));
DEVI unsigned pk2(float lo, float hi) { bf16v2 v = {(__bf16)lo, (__bf16)hi}; return __builtin_bit_cast(unsigned, v); }
DEVI bf16_t f2bf(float f) { return (bf16_t)(pk2(f, 0.f) & 0xffffu); }
DEVI float bf2f(bf16_t h) { return __uint_as_float(((unsigned)h) << 16); }
DEVI float bflo(unsigned u) { return __uint_as_float(u << 16); }
DEVI float bfhi(unsigned u) { return __uint_as_float(u & 0xffff0000u); }
DEVI f32x4 mfma16(bf16x8 a, bf16x8 b, f32x4 c) { return __builtin_amdgcn_mfma_f32_16x16x32_bf16(a, b, c, 0, 0, 0); }
DEVI void unpack8(u32x4 u, float* v) { v[0] = bflo(u.x); v[1] = bfhi(u.x); v[2] = bflo(u.y); v[3] = bfhi(u.y); v[4] = bflo(u.z); v[5] = bfhi(u.z); v[6] = bflo(u.w); v[7] = bfhi(u.w); }
DEVI u32x4 pack8(const float* v) { u32x4 o; o.x = pk2(v[0], v[1]); o.y = pk2(v[2], v[3]); o.z = pk2(v[4], v[5]); o.w = pk2(v[6], v[7]); return o; }
DEVI float dpp_xor1(float x) { return __uint_as_float((unsigned)__builtin_amdgcn_mov_dpp((int)__float_as_uint(x), 0xB1, 0xF, 0xF, true)); }
DEVI float dpp_xor2(float x) { return __uint_as_float((unsigned)__builtin_amdgcn_mov_dpp((int)__float_as_uint(x), 0x4E, 0xF, 0xF, true)); }
DEVI float red_max_16_32(float x) {
    auto r = __builtin_amdgcn_permlane16_swap(__float_as_uint(x), __float_as_uint(x), false, false); x = fmaxf(__uint_as_float(r[0]), __uint_as_float(r[1]));
    auto q = __builtin_amdgcn_permlane32_swap(__float_as_uint(x), __float_as_uint(x), false, false); return fmaxf(__uint_as_float(q[0]), __uint_as_float(q[1]));
}
DEVI float red_sum_16_32(float x) {
    auto r = __builtin_amdgcn_permlane16_swap(__float_as_uint(x), __float_as_uint(x), false, false); x = __uint_as_float(r[0]) + __uint_as_float(r[1]);
    auto q = __builtin_amdgcn_permlane32_swap(__float_as_uint(x), __float_as_uint(x), false, false); return __uint_as_float(q[0]) + __uint_as_float(q[1]);
}
DEVI bf16_t raw16(const u32x4 u, int i) { const unsigned w = (i >> 1) == 0 ? u.x : ((i >> 1) == 1 ? u.y : ((i >> 1) == 2 ? u.z : u.w)); return (bf16_t)((i & 1) ? (w >> 16) : (w & 0xffffu)); }
DEVI float silu_f(float v) { return v * __builtin_amdgcn_rcpf(1.f + __builtin_amdgcn_exp2f(v * -1.44269504f)); }

DEVI void transpose_tile(const float* __restrict__ W, int N, int Nvalid, bf16_t* __restrict__ WT, int Kdst, int k0, int n0, int mode, float* tile) {
    const int t = tidx();
    __syncthreads();
    {
        const int c4 = (t & 63) * 4;
        float4 v[8];
#pragma unroll
        for (int i = 0; i < 8; ++i) { const int kk = (t >> 6) + 8 * i; v[i] = make_float4(0.f, 0.f, 0.f, 0.f); if (n0 + c4 < Nvalid) v[i] = *(const float4*)(W + (size_t)(k0 + kk) * N + n0 + c4); }
#pragma unroll
        for (int i = 0; i < 8; ++i) { const int kk = (t >> 6) + 8 * i; tile[kk * 257 + c4 + 0] = v[i].x; tile[kk * 257 + c4 + 1] = v[i].y; tile[kk * 257 + c4 + 2] = v[i].z; tile[kk * 257 + c4 + 3] = v[i].w; }
    }
    __syncthreads();
    const int nn = t >> 1, ks = (t & 1) * 32;
    const int n = n0 + nn;
    int orow = n;
    if (mode == 1) { if (n < FFH) orow = (n >> 7) * 256 + (n & 127); else { const int j = n - FFH; orow = (j >> 7) * 256 + 128 + (j & 127); } }
    { const int q5 = orow & 31; orow = (orow & ~31) + ((q5 >> 2) & 1) * 16 + (q5 >> 3) * 4 + (q5 & 3); }
#pragma unroll
    for (int q = 0; q < 4; ++q) {
        float v[8];
#pragma unroll
        for (int j = 0; j < 8; ++j) v[j] = tile[(ks + q * 8 + j) * 257 + nn];
        *(u32x4*)(WT + (size_t)orow * Kdst + k0 + ks + q * 8) = pack8(v);
    }
}

DEVI void prep_phase(const Params& p, unsigned char* lds, const int lsel = 0, const int bid0 = 0, const int nblk = 0) {
    const int t = tidx();
    constexpr int PER_L = 144 + 64 + 352 + 176;
    constexpr int N_MOD = 192, N_TAB = 9;
    const int NITEMS = N_MOD + N_TAB + (lsel == 0 ? 208 : (lsel == 1 ? 736 : 528));
    float* fl = (float*)lds;
    const int it0 = lsel ? N_MOD + N_TAB + ((int)blockIdx.x - bid0) : (int)blockIdx.x, itstep = lsel ? nblk : (int)gridDim.x;
    for (int it = it0; it < NITEMS; it += itstep) {
        if (it < N_MOD) {
            const int l = it / 96, j0 = (it % 96) * 64;
            float* sc = fl; float* red = fl + 3072;
            __syncthreads();
            for (int i = t; i < 3072; i += NT) { const int v = i >> 10, k = i & 1023; const float cv = v < 2 ? p.c[v * 1024 + k] : p.c_ctx[k]; sc[i] = cv / (1.f + expf(-cv)); }
            __syncthreads();
            const int jj = t & 63, kg = t >> 6;
            const float* w = p.w_mod + (size_t)l * 1024 * 6144 + j0 + jj;
            float a0 = 0.f, a1 = 0.f, a2 = 0.f;
#pragma unroll 1
            for (int k0 = kg * 128; k0 < kg * 128 + 128; k0 += 32) {
                float wv[32];
#pragma unroll
                for (int i = 0; i < 32; ++i) wv[i] = w[(size_t)(k0 + i) * 6144];
#pragma unroll
                for (int i = 0; i < 32; ++i) { a0 += sc[k0 + i] * wv[i]; a1 += sc[1024 + k0 + i] * wv[i]; a2 += sc[2048 + k0 + i] * wv[i]; }
            }
            red[(kg * 3 + 0) * 64 + jj] = a0; red[(kg * 3 + 1) * 64 + jj] = a1; red[(kg * 3 + 2) * 64 + jj] = a2;
            __syncthreads();
            if (t < 192) {
                const int v = t >> 6, j = t & 63; float s = 0.f;
#pragma unroll
                for (int g = 0; g < 8; ++g) s += red[(g * 3 + v) * 64 + j];
                ((float*)(p.ws + WS_MOD))[(l * 3 + v) * 6144 + j0 + j] = s + p.b_mod[l * 6144 + j0 + j];
            }
        } else if (it < N_MOD + N_TAB) {
            const int ti = it - N_MOD;
            if (ti == 0) {
                float* rope = (float*)(p.ws + WS_ROPE);
                for (int i = t; i < 128 * 16; i += NT) { const int pos = i >> 4, f = i & 15; const float inv = powf(10000.f, -(float)(2 * f) / 32.f); const float ang = (float)pos * inv; rope[i] = cosf(ang); rope[2048 + i] = sinf(ang); }
                bf16_t* d128 = (bf16_t*)(p.ws + WS_D128);
                for (int i = t; i < 256 * 128; i += NT) { const int r = i >> 7, n1 = i & 127; const int part = (r >> 4) & 1, k1 = (r >> 5) * 16 + (r & 15); const int m = (n1 * k1) & 127; const float a = (float)m / 64.f; d128[i] = f2bf(part == 0 ? cospif(a) : -sinpif(a)); }
                bf16_t* t64 = (bf16_t*)(p.ws + WS_T64);
                for (int i = t; i < 128 * 128; i += NT) { const int r = i >> 7, kk = i & 127; const int mt = r >> 4, po = mt & 1, k2 = (mt >> 1) * 16 + (r & 15), part = kk >> 6, n2 = kk & 63; const int m = (n2 * k2) & 63; const float a = (float)m / 32.f; const float cs = cospif(a), sn = sinpif(a);
                    t64[i] = f2bf(po == 0 ? (part == 0 ? cs : sn) : (part == 0 ? -sn : cs)); }
            } else {
                const int l = (ti - 1) >> 2, g = (ti - 1) & 3;
                const float* wf = p.wf + (size_t)(l * 4 + g) * 4096;
                bf16_t* mmt = (bf16_t*)(p.ws + WS_MMT) + (size_t)(l * 4 + g) * 8192;
                const float nrm = 1.0f / sqrtf(8192.f * 64.f);
                __syncthreads();
                if (t < 64) { fl[t] = cospif((float)t / 32.f); fl[64 + t] = sinpif((float)t / 32.f); }
                for (int i = t; i < 4096; i += NT) fl[128 + i] = wf[i];
                __syncthreads();
                for (int i = t; i < 8192; i += NT) { const int e = i >> 7, cp = i & 127, part = cp >> 6, c = cp & 63; float s = 0.f;
#pragma unroll 8
                    for (int e0 = 0; e0 < 64; ++e0) s += fl[part * 64 + ((c * e0) & 63)] * fl[128 + e0 * 64 + e];
                    mmt[i] = f2bf(s * nrm); }
            }
        } else {
            int r = it - N_MOD - N_TAB; int l = 0;
            if (lsel == 1) { if (r < 528) r += 208; else { r -= 528; l = 1; } }
            else if (lsel == 2) { r += 208; l = 1; }
            if (r < 144) { transpose_tile(p.w_in + (size_t)l * DM * INW, INW, INW, (bf16_t*)(p.ws + WS_WIN + l * SZ_WIN), DM, (r / 9) * 64, (r % 9) * 256, 0, fl); continue; } r -= 144;
            if (r < 64) { transpose_tile(p.w_out + (size_t)l * DM * DM, DM, DM, (bf16_t*)(p.ws + WS_WOUT + l * SZ_WOUT), DM, (r / 4) * 64, (r % 4) * 256, 0, fl); continue; } r -= 64;
            if (r < 352) { transpose_tile(p.w_fi + (size_t)l * DM * 2 * FFH, 2 * FFH, 2 * FFH, (bf16_t*)(p.ws + WS_WFI + l * SZ_WFI), DM, (r / 22) * 64, (r % 22) * 256, 1, fl); continue; } r -= 352;
            transpose_tile(p.w_fo + (size_t)l * FFH * DM, DM, DM, (bf16_t*)(p.ws + WS_WFO + l * SZ_WFO), FFH, (r / 4) * 64, (r % 4) * 256, 0, fl);
        }
    }
}

DEVI void norm_phase(const Params& p, int l, int which) {
    const int lane = tidx() & 63, wave = tidx() >> 6;
    const int nrows = (which == 1 && l == 1) ? TOKL : TOK;
    const float* MOD = (const float*)(p.ws + WS_MOD);
    const float* XC = (const float*)(p.ws + WS_XC);
    bf16_t* H = (bf16_t*)(p.ws + WS_H);
    const float* g = (which ? p.g2 : p.g1) + l * DM;
    for (int r = blockIdx.x * 8 + wave; r < nrows; r += gridDim.x * 8) {
        const float* src; int vec;
        if (r < TOKL) { src = ((which == 0 && l == 0) ? p.x : p.out) + (size_t)r * DM; vec = r >> 13; }
        else { const int rc = r - TOKL; src = ((which == 0 && l == 0) ? p.ctx : XC) + (size_t)rc * DM; vec = 2; }
        const float* mod = MOD + (l * 3 + vec) * 6144;
        const float* sh = mod + (which ? 3 * DM : 0);
        const float* sc = mod + (which ? 4 * DM : DM);
        f32x4 v[4]; float ss = 0.f;
        const bool fold = (r >= TOKL) && ((which == 1 && l == 0) || (which == 0 && l == 1));
#pragma unroll
        for (int j = 0; j < 4; ++j) {
            v[j] = *(const f32x4*)(src + j * 256 + lane * 4);
            if (fold) {
                const float* pb = (const float*)(p.ws + WS_PART) + (size_t)(r - TOKL) * DM + j * 256 + lane * 4;
#pragma unroll
                for (int s = 0; s < 4; ++s) v[j] += *(const f32x4*)(pb + (size_t)s * TOKC * DM);
                *(f32x4*)((float*)(p.ws + WS_XC) + (size_t)(r - TOKL) * DM + j * 256 + lane * 4) = v[j];
            }
            ss += v[j].x * v[j].x + v[j].y * v[j].y + v[j].z * v[j].z + v[j].w * v[j].w;
        }
#pragma unroll
        for (int o = 1; o < 64; o <<= 1) ss += __shfl_xor(ss, o);
        const float rstd = rsqrtf(ss * (1.f / DM) + 1e-6f);
#pragma unroll
        for (int j = 0; j < 4; ++j) {
            const int k = j * 256 + lane * 4;
            const f32x4 gv = *(const f32x4*)(g + k), sv = *(const f32x4*)(sc + k), hv = *(const f32x4*)(sh + k);
            const f32x4 y = (v[j] * rstd) * gv * (sv + 1.f) + hv;
            u32x2 o; o.x = pk2(y.x, y.y); o.y = pk2(y.z, y.w);
            *(u32x2*)(H + (size_t)r * DM + k) = o;
            if (which == 0 && l == 0 && r >= TOKL) *(f32x4*)((float*)(p.ws + WS_XC) + (size_t)(r - TOKL) * DM + k) = v[j];
        }
    }
}

template <class Epi>
DEVI void gemm_phase(const bf16_t* __restrict__ A, const bf16_t* __restrict__ Bt, int K, int nM, int nN, const Epi& epi, unsigned char* lds) {
    bf16_t* As = (bf16_t*)lds; bf16_t* Bs = As + 256 * 72;
    const int t = tidx(), lane = t & 63, wid = t >> 6, wr = wid >> 2, wc = wid & 3, fr = lane & 15, fq = lane >> 4;
    const int ntile = nM * nN;
    for (int tile = blockIdx.x; tile < ntile; tile += gridDim.x) {
        const int pm = tile / nN, pn = tile % nN;
        f32x4 acc[2][2][4][2];
#pragma unroll
        for (int ai = 0; ai < 2; ++ai)
#pragma unroll
            for (int bj = 0; bj < 2; ++bj)
#pragma unroll
                for (int m = 0; m < 4; ++m)
#pragma unroll
                    for (int n = 0; n < 2; ++n) acc[ai][bj][m][n] = (f32x4){0.f, 0.f, 0.f, 0.f};
        const bf16_t* Ab = A + (size_t)pm * 256 * K; const bf16_t* Bb = Bt + (size_t)pn * 256 * K;
        for (int k0 = 0; k0 < K; k0 += 64) {
            u32x4 ra[4], rb[4];
#pragma unroll
            for (int i = 0; i < 4; ++i) { const int id = i * NT + t, row = id >> 3, seg = id & 7; ra[i] = *(const u32x4*)(Ab + (size_t)row * K + k0 + seg * 8); rb[i] = *(const u32x4*)(Bb + (size_t)row * K + k0 + seg * 8); }
            __syncthreads();
#pragma unroll
            for (int i = 0; i < 4; ++i) { const int id = i * NT + t, row = id >> 3, seg = id & 7; *(u32x4*)(As + row * 72 + seg * 8) = ra[i]; *(u32x4*)(Bs + row * 72 + seg * 8) = rb[i]; }
            __syncthreads();
#pragma unroll
            for (int ks = 0; ks < 2; ++ks) {
                bf16x8 af[2][4], bfg[2][2];
#pragma unroll
                for (int ai = 0; ai < 2; ++ai)
#pragma unroll
                    for (int m = 0; m < 4; ++m) af[ai][m] = *(const bf16x8*)(As + (ai * 128 + wr * 64 + m * 16 + fr) * 72 + ks * 32 + fq * 8);
#pragma unroll
                for (int bj = 0; bj < 2; ++bj)
#pragma unroll
                    for (int n = 0; n < 2; ++n) bfg[bj][n] = *(const bf16x8*)(Bs + (bj * 128 + wc * 32 + n * 16 + fr) * 72 + ks * 32 + fq * 8);
#pragma unroll
                for (int ai = 0; ai < 2; ++ai)
#pragma unroll
                    for (int bj = 0; bj < 2; ++bj)
#pragma unroll
                        for (int m = 0; m < 4; ++m)
#pragma unroll
                            for (int n = 0; n < 2; ++n) acc[ai][bj][m][n] = mfma16(bfg[bj][n], af[ai][m], acc[ai][bj][m][n]);
            }
        }
        epi(acc, pm, pn, wr, wc, fr, fq);
    }
}


typedef __attribute__((address_space(3))) unsigned char ldsb_t;
typedef __attribute__((address_space(3))) unsigned ldsu_t;
DEVI int g8_lds_byte(int r, int c) { const int st = (r >> 4) * 2 + (c >> 5), rr = r & 15, cc = c & 31, ob = rr * 64 + cc * 2; return st * 1024 + (ob ^ (((ob >> 9) & 1) << 5)); }
DEVI void g8_stage_rc(int b, int& R, int& C) { const int st = b / 1024, sb = b % 1024, swz = sb ^ (((sb >> 9) & 1) << 5); R = (st >> 1) * 16 + swz / 64; C = (st & 1) * 32 + (swz % 64) / 2; }
#define G8_SA(b, h) (shm + ((b) * 2 + (h)) * 16384)
#define G8_SB(b, h) (shm + (4 + (b) * 2 + (h)) * 16384)
#define G8_STAGE(Pp, BASE, br, kt) do { const char* _g = (const char*)((BASE) + (long)(br) * K + (long)(kt) * 64); \
    __builtin_amdgcn_global_load_lds((const unsigned*)(_g + so0), (ldsu_t*)((Pp) + wdst), 16, 0, 0); \
    __builtin_amdgcn_global_load_lds((const unsigned*)(_g + (size_t)128 * K + so0), (ldsu_t*)((Pp) + wdst + 8192), 16, 0, 0); } while (0)
#define G8_LDA(b, h) _Pragma("unroll") for (int m = 0; m < 4; ++m) _Pragma("unroll") for (int k = 0; k < 2; ++k) At[m][k] = *(const __attribute__((address_space(3))) bf16x8*)(G8_SA(b, h) + aoff + m * 2048 + k * 1024)
#define G8_LDB(dst, b, h) _Pragma("unroll") for (int n = 0; n < 2; ++n) _Pragma("unroll") for (int k = 0; k < 2; ++k) dst[n][k] = *(const __attribute__((address_space(3))) bf16x8*)(G8_SB(b, h) + boff + n * 2048 + k * 1024)
#define G8_MMA(ai, bj, Bx) do { __builtin_amdgcn_s_setprio(1); \
    _Pragma("unroll") for (int m = 0; m < 4; ++m) _Pragma("unroll") for (int n = 0; n < 2; ++n) _Pragma("unroll") for (int k = 0; k < 2; ++k) \
        acc[ai][bj][m][n] = __builtin_amdgcn_mfma_f32_16x16x32_bf16(Bx[n][k], At[m][k], acc[ai][bj][m][n], 0, 0, 0); \
    __builtin_amdgcn_s_setprio(0); } while (0)
#define G8_WV(n) asm volatile("s_waitcnt vmcnt(" #n ")" ::: "memory")
#define G8_WL(n) asm volatile("s_waitcnt lgkmcnt(" #n ")" ::: "memory")
#define G8_BAR __builtin_amdgcn_s_barrier()
#define G8_SCHED __builtin_amdgcn_sched_barrier(0)

template <class Epi>
DEVI void gemm_phase8(const bf16_t* __restrict__ A, const bf16_t* __restrict__ Bt, const int K, const int nM, const int nN, const Epi& epi, unsigned char* lds, const int nsplit = 0) {
    ldsb_t* shm = (ldsb_t*)lds;
    const int t = tidx(), lane = t & 63, wid = t >> 6, wr = wid >> 2, wc = wid & 3, fr = lane & 15, fq = lane >> 4;
    unsigned so0;
    { int r, c; g8_stage_rc(t * 16, r, c); so0 = (unsigned)(r * K + c) * 2u; }
    const int wdst = __builtin_amdgcn_readfirstlane(wid * 1024);
    const int loff = g8_lds_byte(fr, fq * 8);
    const int aoff = loff + wr * 8192, boff = loff + wc * 4096;
    const int nwg = nM * nN, G = gridDim.x, ntk = K / 64;
    const int nunits = nwg + 2 * nN * nsplit;
    auto decode = [&](long L, int& pm, int& pn, int& kbeg, int& nt, int& part) {
        kbeg = 0; nt = ntk; part = -1;
        if (L < nwg) {
            int wgid = (int)L; { const int q = nwg / 8, r = nwg % 8, xcd = wgid % 8, off = wgid / 8; wgid = (xcd < r ? xcd * (q + 1) : r * (q + 1) + (xcd - r) * q) + off; }
            const int nig = 8 * nN, gid = wgid / nig, fm = gid * 8, gsz = (nM - fm) < 8 ? (nM - fm) : 8;
            pm = fm + ((wgid % nig) % gsz); pn = (wgid % nig) / gsz;
        } else {
            const int v = (int)L - nwg, sp = v % nsplit, tl = v / nsplit;
            pm = 64 + tl / nN; pn = tl % nN; part = sp;
            const int base = (ntk / nsplit) & ~1, extra = (ntk - base * nsplit) / 2;
            nt = base + (sp < extra ? 2 : 0); kbeg = sp * base + 2 * (sp < extra ? sp : extra);
        }
    };
    int pm = 0, pn = 0, kbeg = 0, nt = ntk, part = -1;
    if ((long)blockIdx.x >= nunits) return;
    decode(blockIdx.x, pm, pn, kbeg, nt, part);
    const bf16_t* Au = A + (size_t)pm * 256 * K + (size_t)kbeg * 64; const bf16_t* Bu = Bt + (size_t)pn * 256 * K + (size_t)kbeg * 64;
    f32x4 acc[2][2][4][2];
#pragma unroll
    for (int ai = 0; ai < 2; ++ai)
#pragma unroll
        for (int bj = 0; bj < 2; ++bj)
#pragma unroll
            for (int m = 0; m < 4; ++m)
#pragma unroll
                for (int n = 0; n < 2; ++n) acc[ai][bj][m][n] = (f32x4){0.f, 0.f, 0.f, 0.f};
    bf16x8 At[4][2], B0[2][2], B1[2][2];
    G8_WV(0);
    G8_STAGE(G8_SB(0, 0), Bu, 0, 0); G8_STAGE(G8_SB(0, 1), Bu, 128, 0); G8_STAGE(G8_SA(0, 0), Au, 0, 0); G8_STAGE(G8_SA(0, 1), Au, 128, 0);
    if (wr == 1) G8_BAR;
    G8_WV(2); G8_BAR;
    G8_STAGE(G8_SB(1, 0), Bu, 0, 1); G8_STAGE(G8_SA(1, 0), Au, 0, 1); G8_STAGE(G8_SB(1, 1), Bu, 128, 1);
    G8_WV(6); G8_BAR;
    for (int it = 0;; ++it) {
        int npm = pm, npn = pn, nkbeg = kbeg, nnt = nt, npart = part;
        const long Ln = (long)(it + 1) * G + blockIdx.x; const bool has_next = Ln < nunits;
        if (has_next) decode(Ln, npm, npn, nkbeg, nnt, npart);
        const bf16_t* nAu = has_next ? A + (size_t)npm * 256 * K + (size_t)nkbeg * 64 : Au; const bf16_t* nBu = has_next ? Bt + (size_t)npn * 256 * K + (size_t)nkbeg * 64 : Bu;
        for (int kt = 0; kt < nt; kt += 2) {
            const bool lastk = (kt == nt - 2);
            const bf16_t* A2 = lastk ? nAu : Au; const bf16_t* B2 = lastk ? nBu : Bu; const int k2 = lastk ? 0 : kt + 2;
            G8_LDB(B0, 0, 0); G8_LDB(B1, 0, 1); G8_SCHED; G8_LDA(0, 0); G8_STAGE(G8_SA(1, 1), Au, 128, kt + 1);
            G8_WV(8); G8_WL(0); G8_BAR; G8_MMA(0, 0, B0); G8_MMA(0, 1, B1); G8_BAR; G8_SCHED;
            G8_LDA(0, 1); G8_STAGE(G8_SB(0, 0), B2, 0, k2); G8_STAGE(G8_SB(0, 1), B2, 128, k2); G8_STAGE(G8_SA(0, 0), A2, 0, k2);
            G8_WV(8); G8_WL(0); G8_BAR; G8_MMA(1, 0, B0); G8_MMA(1, 1, B1); G8_BAR; G8_SCHED;
            G8_LDB(B0, 1, 0); G8_LDB(B1, 1, 1); G8_SCHED; G8_LDA(1, 0); G8_STAGE(G8_SA(0, 1), A2, 128, k2);
            G8_WV(8); G8_WL(0); G8_BAR; G8_MMA(0, 0, B0); G8_MMA(0, 1, B1); G8_BAR; G8_SCHED;
            G8_LDA(1, 1); G8_STAGE(G8_SB(1, 0), B2, 0, k2 + 1); G8_STAGE(G8_SB(1, 1), B2, 128, k2 + 1); G8_STAGE(G8_SA(1, 0), A2, 0, k2 + 1);
            G8_WV(8); G8_WL(0); G8_BAR; G8_MMA(1, 0, B0); G8_MMA(1, 1, B1); G8_BAR; G8_SCHED;
        }
        if (wr == 0) G8_BAR;
        epi(acc, pm, pn, wr, wc, fr, fq, part);
        if (!has_next) break;
#pragma unroll
        for (int ai = 0; ai < 2; ++ai)
#pragma unroll
            for (int bj = 0; bj < 2; ++bj)
#pragma unroll
                for (int m = 0; m < 4; ++m)
#pragma unroll
                    for (int n = 0; n < 2; ++n) acc[ai][bj][m][n] = (f32x4){0.f, 0.f, 0.f, 0.f};
        pm = npm; pn = npn; kbeg = nkbeg; nt = nnt; part = npart; Au = nAu; Bu = nBu;
        if (wr == 1) G8_BAR;
    }
    G8_WV(0);
    G8_BAR;
}


struct EpiInProj {
    bf16_t* P; bf16_t* VTL; bf16_t* VTC;
    DEVI void operator()(const f32x4 (&acc)[2][2][4][2], int pm, int pn, int wr, int wc, int fr, int fq, int part = -1) const {
#pragma unroll
        for (int ai = 0; ai < 2; ++ai)
#pragma unroll
            for (int m = 0; m < 4; ++m) {
                const int r = pm * 256 + ai * 128 + wr * 64 + m * 16 + fr;
#pragma unroll
                for (int bj = 0; bj < 2; ++bj) {
                    const int c = pn * 256 + bj * 128 + wc * 32 + fq * 8;
                    const f32x4 v0 = acc[ai][bj][m][0], v1 = acc[ai][bj][m][1];
                    if (pn == 2 && bj == 1) {
                        const int di = c - 640, kvh = di >> 6, d = di & 63;
                        bf16_t* dst; int stride;
                        if (r < TOKL) { const int b = r >> 13, tt = r & 8191; dst = VTL + ((size_t)((b * 2 + kvh) * 64 + d)) * SEQ + tt; stride = SEQ; }
                        else { const int rc = r - TOKL, b = rc >> 8, tt = rc & 255; dst = VTC + ((size_t)((b * 2 + kvh) * 64 + d)) * CTXL + tt; stride = CTXL; }
                        dst[0] = f2bf(v0.x); dst[stride] = f2bf(v0.y); dst[2 * stride] = f2bf(v0.z); dst[3 * stride] = f2bf(v0.w);
                        dst[4 * stride] = f2bf(v1.x); dst[5 * stride] = f2bf(v1.y); dst[6 * stride] = f2bf(v1.z); dst[7 * stride] = f2bf(v1.w);
                    } else {
                        u32x4 o; o.x = pk2(v0.x, v0.y); o.y = pk2(v0.z, v0.w); o.z = pk2(v1.x, v1.y); o.w = pk2(v1.z, v1.w);
                        *(u32x4*)(P + (size_t)r * INWP + c) = o;
                    }
                }
            }
    }
};
struct EpiResid {
    const float* baseL; const float* baseC; float* outL; float* outC; const float* mod; int goff; float* partbuf;
    DEVI void operator()(const f32x4 (&acc)[2][2][4][2], int pm, int pn, int wr, int wc, int fr, int fq, int part = -1) const {
        const int vec = pm < 32 ? 0 : (pm < 64 ? 1 : 2);
        const int r0 = pm * 256 + wr * 64 + fr, c0 = pn * 256 + wc * 32 + fq * 8;
        const float* gt = mod + vec * 6144 + goff + c0;
        f32x4 gv[2][2];
#pragma unroll
        for (int bj = 0; bj < 2; ++bj)
#pragma unroll
            for (int n = 0; n < 2; ++n) gv[bj][n] = *(const f32x4*)(gt + bj * 128 + n * 4);
        if (part >= 0) {
#pragma unroll
            for (int ai = 0; ai < 2; ++ai)
#pragma unroll
                for (int m = 0; m < 4; ++m)
#pragma unroll
                    for (int bj = 0; bj < 2; ++bj)
#pragma unroll
                        for (int n = 0; n < 2; ++n)
                            *(f32x4*)(partbuf + ((size_t)part * TOKC + (r0 + ai * 128 + m * 16 - TOKL)) * DM + c0 + bj * 128 + n * 4) = gv[bj][n] * acc[ai][bj][m][n];
            return;
        }
        const float* base = pm < 64 ? baseL + (size_t)r0 * DM + c0 : baseC + (size_t)(r0 - TOKL) * DM + c0;
        float* dst = pm < 64 ? outL + (size_t)r0 * DM + c0 : outC + (size_t)(r0 - TOKL) * DM + c0;
#pragma unroll
        for (int ai = 0; ai < 2; ++ai) {
            f32x4 bv[4][2][2];
#pragma unroll
            for (int m = 0; m < 4; ++m)
#pragma unroll
                for (int bj = 0; bj < 2; ++bj)
#pragma unroll
                    for (int n = 0; n < 2; ++n) bv[m][bj][n] = *(const f32x4*)(base + (size_t)(ai * 128 + m * 16) * DM + bj * 128 + n * 4);
#pragma unroll
            for (int m = 0; m < 4; ++m)
#pragma unroll
                for (int bj = 0; bj < 2; ++bj)
#pragma unroll
                    for (int n = 0; n < 2; ++n) *(f32x4*)(dst + (size_t)(ai * 128 + m * 16) * DM + bj * 128 + n * 4) = bv[m][bj][n] + gv[bj][n] * acc[ai][bj][m][n];
        }
    }
};
struct EpiSwiglu {
    bf16_t* HID;
    DEVI void operator()(const f32x4 (&acc)[2][2][4][2], int pm, int pn, int wr, int wc, int fr, int fq, int part = -1) const {
#pragma unroll
        for (int ai = 0; ai < 2; ++ai)
#pragma unroll
            for (int m = 0; m < 4; ++m) {
                const int r = pm * 256 + ai * 128 + wr * 64 + m * 16 + fr;
                const int c = pn * 128 + wc * 32 + fq * 8;
                const f32x4 g0 = acc[ai][0][m][0], u0 = acc[ai][1][m][0], g1 = acc[ai][0][m][1], u1 = acc[ai][1][m][1];
                u32x4 o; o.x = pk2(silu_f(g0.x) * u0.x, silu_f(g0.y) * u0.y); o.y = pk2(silu_f(g0.z) * u0.z, silu_f(g0.w) * u0.w);
                o.z = pk2(silu_f(g1.x) * u1.x, silu_f(g1.y) * u1.y); o.w = pk2(silu_f(g1.z) * u1.z, silu_f(g1.w) * u1.w);
                *(u32x4*)(HID + (size_t)r * FFH + c) = o;
            }
    }
};

constexpr int ROPE_LDS_OFF = 114688;
DEVI void stage_norm_rope(const u32x4 raw, int row, int seg, const float* __restrict__ gn, bool rope, int pos, const float* ropel, float scale, bf16_t* dst) {
    float v[8]; unpack8(raw, v);
    float ss = 0.f;
#pragma unroll
    for (int j = 0; j < 8; ++j) ss += v[j] * v[j];
    ss += dpp_xor1(ss); ss += dpp_xor2(ss); ss += __shfl_xor(ss, 4);
    const float rstd = rsqrtf(ss * (1.f / 64.f) + 1e-6f);
    const f32x4 g0 = *(const f32x4*)(gn + seg * 8), g1 = *(const f32x4*)(gn + seg * 8 + 4);
    const float gg[8] = {g0.x, g0.y, g0.z, g0.w, g1.x, g1.y, g1.z, g1.w};
#pragma unroll
    for (int j = 0; j < 8; ++j) v[j] = v[j] * rstd * gg[j];
    float o[8];
    if (rope) {
        const int ap = (seg < 4) ? (pos >> 6) : (pos & 63);
        const float* tb = ropel + ap * 16 + (seg & 1) * 8;
        const f32x4 c0 = *(const f32x4*)tb, c1 = *(const f32x4*)(tb + 4), s0 = *(const f32x4*)(tb + 2048), s1 = *(const f32x4*)(tb + 2052);
        const float cs[8] = {c0.x, c0.y, c0.z, c0.w, c1.x, c1.y, c1.z, c1.w}, sn[8] = {s0.x, s0.y, s0.z, s0.w, s1.x, s1.y, s1.z, s1.w};
#pragma unroll
        for (int j = 0; j < 8; ++j) { const float pv = dpp_xor2(v[j]); o[j] = ((seg & 2) ? (v[j] * cs[j] + pv * sn[j]) : (v[j] * cs[j] - pv * sn[j])) * scale; }
    } else {
#pragma unroll
        for (int j = 0; j < 8; ++j) o[j] = v[j] * scale;
    }
    *(u32x4*)(dst + row * 72 + seg * 8) = pack8(o);
}

DEVI void attn_item(const Params& p, int l, int item, unsigned char* lds) {
    const int t = tidx(), lane = t & 63, wid = t >> 6, fr = lane & 15, fq = lane >> 4;
    const bf16_t* P = (const bf16_t*)(p.ws + WS_P);
    const bf16_t* VTL = (const bf16_t*)(p.ws + WS_VTL);
    const bf16_t* VTC = (const bf16_t*)(p.ws + WS_VTC);
    bf16_t* MIX = (bf16_t*)(p.ws + WS_MIX);
    const float* ropel = (const float*)(lds + ROPE_LDS_OFF);
    const float* qg = p.qg + l * 64; const float* kgn = p.kg + l * 64;
    bf16_t* Qs = (bf16_t*)lds;
    bf16_t* Ks = Qs + 512 * 72;
    bf16_t* Vs = Ks + 64 * 72;
    int b, qb, kvh; bool isctx; int qrow0;
    if (item < 256) { isctx = false; b = item >> 7; qb = (item >> 1) & 63; kvh = item & 1; qrow0 = b * SEQ + qb * 128; }
    else { const int ci = item - 256; isctx = true; b = ci >> 2; qb = (ci >> 1) & 1; kvh = ci & 1; qrow0 = TOKL + b * CTXL + qb * 128; }
    const int lo = isctx ? 0 : (qb * 2 - 2 < 0 ? 0 : qb * 2 - 2), hi = isctx ? -1 : (qb * 2 + 3 > 127 ? 127 : qb * 2 + 3);
    const int nl = hi - lo + 1, ntile = nl + 4;
    const int key = t >> 3, seg = t & 7;
    const size_t vrow = (size_t)((b * 2 + kvh) * 64 + key);
    u32x4 kraw, vraw;
    {
        const bool loc0 = nl > 0; const int kt0 = loc0 ? lo : 0;
        const size_t krow = loc0 ? ((size_t)b * SEQ + kt0 * 64 + key) : ((size_t)TOKL + b * CTXL + kt0 * 64 + key);
        kraw = *(const u32x4*)(P + krow * INWP + 512 + kvh * 64 + seg * 8);
        vraw = *(const u32x4*)(loc0 ? (VTL + vrow * SEQ + kt0 * 64 + seg * 8) : (VTC + vrow * CTXL + kt0 * 64 + seg * 8));
    }
    __syncthreads();
    {
        u32x4 qraw[8];
#pragma unroll
        for (int i = 0; i < 8; ++i) { const int id = i * NT + t, row = id >> 3, g = row >> 7, rr = row & 127; qraw[i] = *(const u32x4*)(P + (size_t)(qrow0 + rr) * INWP + (kvh * 4 + g) * 64 + (id & 7) * 8); }
#pragma unroll
        for (int i = 0; i < 8; ++i) { const int id = i * NT + t, row = id >> 3, rr = row & 127; stage_norm_rope(qraw[i], row, id & 7, qg, !isctx, qb * 128 + rr, ropel, 0.125f * 1.44269504f, Qs); }
    }
    {
        const bool loc0 = nl > 0; const int kt0 = loc0 ? lo : 0;
        stage_norm_rope(kraw, key, seg, kgn, loc0, kt0 * 64 + key, ropel, 1.f, Ks);
        *(u32x4*)(Vs + key * 72 + seg * 8) = vraw;
    }
    __syncthreads();
    const int g = wid >> 1, half = wid & 1;
    const bf16_t* Qw = Qs + (g * 128 + half * 64 + fr) * 72 + fq * 8;
    const float sinkv = p.sink[l * 8 + kvh * 4 + g] * 1.44269504f;
    float mrun[4], lrun[4]; f32x4 o[4][4];
#pragma unroll
    for (int n = 0; n < 4; ++n) { mrun[n] = sinkv; lrun[n] = fq == 0 ? 1.f : 0.f;
#pragma unroll
        for (int dt = 0; dt < 4; ++dt) o[dt][n] = (f32x4){0.f, 0.f, 0.f, 0.f}; }
    for (int ti = 0; ti < ntile; ++ti) {
        const bool local = ti < nl; const int kt = local ? lo + ti : ti - nl;
        const bool more = ti + 1 < ntile;
        const bool nloc = (ti + 1) < nl; const int nkt = nloc ? lo + ti + 1 : ti + 1 - nl;
        if (more) {
            const size_t krow = nloc ? ((size_t)b * SEQ + nkt * 64 + key) : ((size_t)TOKL + b * CTXL + nkt * 64 + key);
            kraw = *(const u32x4*)(P + krow * INWP + 512 + kvh * 64 + seg * 8);
            vraw = *(const u32x4*)(nloc ? (VTL + vrow * SEQ + nkt * 64 + seg * 8) : (VTC + vrow * CTXL + nkt * 64 + seg * 8));
        }
        const bool domask = local && (kt < 2 * qb || kt > 2 * qb + 1);
#pragma unroll 1
        for (int kh = 0; kh < 2; ++kh) {
            f32x4 s[2][4];
#pragma unroll
            for (int m = 0; m < 2; ++m)
#pragma unroll
                for (int n = 0; n < 4; ++n) s[m][n] = (f32x4){0.f, 0.f, 0.f, 0.f};
#pragma unroll
            for (int ks = 0; ks < 2; ++ks) {
                bf16x8 qf[4];
#pragma unroll
                for (int n = 0; n < 4; ++n) qf[n] = *(const bf16x8*)(Qw + n * 16 * 72 + ks * 32);
#pragma unroll
                for (int m = 0; m < 2; ++m) {
                    const bf16x8 kf = *(const bf16x8*)(Ks + ((kh * 2 + m) * 16 + fr) * 72 + ks * 32 + fq * 8);
#pragma unroll
                    for (int n = 0; n < 4; ++n) s[m][n] = mfma16(kf, qf[n], s[m][n]);
                }
            }
            if (domask) {
#pragma unroll
                for (int m = 0; m < 2; ++m)
#pragma unroll
                    for (int n = 0; n < 4; ++n)
#pragma unroll
                        for (int j = 0; j < 4; ++j) {
                            const int kpos = kt * 64 + (kh * 2 + m) * 16 + fq * 4 + j, qpos = qb * 128 + half * 64 + n * 16 + fr;
                            const int df = qpos - kpos;
                            if (df > 128 || df < -128) s[m][n][j] = -1e30f;
                        }
            }
#pragma unroll
            for (int n = 0; n < 4; ++n) {
                float mx = -1e30f;
#pragma unroll
                for (int m = 0; m < 2; ++m)
#pragma unroll
                    for (int j = 0; j < 4; ++j) mx = fmaxf(mx, s[m][n][j]);
                if (__builtin_amdgcn_ballot_w64(mx > mrun[n] + 8.f) != 0ull) {
                    mx = red_max_16_32(mx);
                    const float mnew = fmaxf(mrun[n], mx);
                    const float alpha = __builtin_amdgcn_exp2f(mrun[n] - mnew);
                    lrun[n] *= alpha; mrun[n] = mnew;
#pragma unroll
                    for (int dt = 0; dt < 4; ++dt) o[dt][n] = o[dt][n] * alpha;
                }
                const float mref = mrun[n];
                float rs = 0.f;
#pragma unroll
                for (int m = 0; m < 2; ++m)
#pragma unroll
                    for (int j = 0; j < 4; ++j) { const float pv = __builtin_amdgcn_exp2f(s[m][n][j] - mref); s[m][n][j] = pv; rs += pv; }
                lrun[n] += rs;
            }
            {
                bf16x8 pb[4];
#pragma unroll
                for (int n = 0; n < 4; ++n) {
                    u32x4 u; u.x = pk2(s[0][n][0], s[0][n][1]); u.y = pk2(s[0][n][2], s[0][n][3]); u.z = pk2(s[1][n][0], s[1][n][1]); u.w = pk2(s[1][n][2], s[1][n][3]);
                    pb[n] = __builtin_bit_cast(bf16x8, u);
                }
#pragma unroll
                for (int dt = 0; dt < 4; ++dt) {
                    const bf16x4 v0 = *(const bf16x4*)(Vs + (dt * 16 + fr) * 72 + (2 * kh) * 16 + fq * 4);
                    const bf16x4 v1 = *(const bf16x4*)(Vs + (dt * 16 + fr) * 72 + (2 * kh + 1) * 16 + fq * 4);
                    const bf16x8 va = __builtin_shufflevector(v0, v1, 0, 1, 2, 3, 4, 5, 6, 7);
#pragma unroll
                    for (int n = 0; n < 4; ++n) o[dt][n] = mfma16(va, pb[n], o[dt][n]);
                }
            }
        }
        if (more) {
            __syncthreads();
            stage_norm_rope(kraw, key, seg, kgn, nloc, nkt * 64 + key, ropel, 1.f, Ks);
            *(u32x4*)(Vs + key * 72 + seg * 8) = vraw;
            __syncthreads();
        }
    }
#pragma unroll
    for (int n = 0; n < 4; ++n) {
        const float inv = 1.f / red_sum_16_32(lrun[n]);
        const size_t row = (size_t)qrow0 + half * 64 + n * 16 + fr;
#pragma unroll
        for (int dt = 0; dt < 4; ++dt) {
            const f32x4 v = o[dt][n] * inv;
            u32x2 u; u.x = pk2(v.x, v.y); u.y = pk2(v.z, v.w);
            *(u32x2*)(MIX + row * DM + (kvh * 4 + g) * 64 + dt * 16 + fq * 4) = u;
        }
    }
}

DEVI void f1_load(const Params& p, int item, u32x4& a, u32x4& c2) {
    const int t = tidx(), g = item & 3, n2 = (item >> 2) & 63, b = item >> 8, n1 = t >> 2, cs = (t & 3) * 16;
    const bf16_t* src = (const bf16_t*)(p.ws + WS_P) + (size_t)(b * SEQ + 64 * n1 + n2) * INWP + 768 + g * 64 + cs;
    a = *(const u32x4*)src; c2 = *(const u32x4*)(src + 8);
}
DEVI void f1_item(const Params& p, int item, unsigned char* lds, u32x4& a, u32x4& c2, int next) {
    const int t = tidx(), lane = t & 63, w = t >> 6, fr = lane & 15, fq = lane >> 4;
    const int g = item & 3, n2 = (item >> 2) & 63, b = item >> 8;
    const bf16_t* D128 = (const bf16_t*)(p.ws + WS_D128);
    bf16_t* YP = (bf16_t*)(p.ws + WS_YP);
    bf16_t* uT = (bf16_t*)lds;
    __syncthreads();
    {
        const int n1 = t >> 2, cs = (t & 3) * 16;
        const unsigned uu[8] = {a.x, a.y, a.z, a.w, c2.x, c2.y, c2.z, c2.w};
        if (next >= 0) f1_load(p, next, a, c2);
#pragma unroll
        for (int i = 0; i < 8; ++i) { uT[(cs + 2 * i) * 136 + n1] = (bf16_t)(uu[i] & 0xffffu); uT[(cs + 2 * i + 1) * 136 + n1] = (bf16_t)(uu[i] >> 16); }
    }
    __syncthreads();
    f32x4 ar[4], ai[4];
#pragma unroll
    for (int n = 0; n < 4; ++n) { ar[n] = (f32x4){0.f, 0.f, 0.f, 0.f}; ai[n] = (f32x4){0.f, 0.f, 0.f, 0.f}; }
#pragma unroll
    for (int ks = 0; ks < 4; ++ks) {
        const bf16x8 a0 = *(const bf16x8*)(D128 + ((2 * w) * 16 + fr) * 128 + ks * 32 + fq * 8);
        const bf16x8 a1 = *(const bf16x8*)(D128 + ((2 * w + 1) * 16 + fr) * 128 + ks * 32 + fq * 8);
#pragma unroll
        for (int n = 0; n < 4; ++n) {
            const bf16x8 bb = *(const bf16x8*)(uT + (n * 16 + fr) * 136 + ks * 32 + fq * 8);
            ar[n] = mfma16(bb, a0, ar[n]); ai[n] = mfma16(bb, a1, ai[n]);
        }
    }
    {
        const int k1 = 16 * w + fr;
        const float a = (float)(n2 * k1) * (1.f / 8192.f);
        const float tc = __builtin_amdgcn_cosf(a), ts = __builtin_amdgcn_sinf(a);
        bf16_t* yb = YP + ((size_t)((b * 4 + g) * 128 + k1) * 2) * 4096 + n2 * 64 + fq * 4;
#pragma unroll
        for (int n = 0; n < 4; ++n) {
            const f32x4 yr = ar[n], yi = ai[n];
            const f32x4 pr = yr * tc + yi * ts, pi = yi * tc - yr * ts;
            u32x2 ur, ui; ur.x = pk2(pr.x, pr.y); ur.y = pk2(pr.z, pr.w); ui.x = pk2(pi.x, pi.y); ui.y = pk2(pi.z, pi.w);
            *(u32x2*)(yb + n * 16) = ur; *(u32x2*)(yb + 4096 + n * 16) = ui;
        }
    }
}

DEVI void f2_load(const Params& p, int item, bool cx, u32x4& a, u32x4& c2) {
    const int t = tidx(), rowi = t >> 2, cs = (t & 3) * 16;
    const int k1 = cx ? (item & 3) : (item & 127), g = cx ? ((item >> 2) & 3) : ((item >> 7) & 3), b = cx ? (item >> 4) : (item >> 9);
    const bf16_t* src = (const bf16_t*)(p.ws + (cx ? WS_YPC : WS_YP)) + ((size_t)((b * 4 + g) * (cx ? 4 : 128) + k1) * 128 + rowi) * 64 + cs;
    a = *(const u32x4*)src; c2 = *(const u32x4*)(src + 8);
}
DEVI void f2_item(const Params& p, int l, int item, unsigned char* lds, const bool cx, u32x4& a, u32x4& c2, int next, bool nextcx) {
    const int t = tidx(), lane = t & 63, w = t >> 6, fr = lane & 15, fq = lane >> 4;
    const int k1 = cx ? (item & 3) : (item & 127), g = cx ? ((item >> 2) & 3) : ((item >> 7) & 3), b = cx ? (item >> 4) : (item >> 9);
    const bf16_t* T64 = (const bf16_t*)(p.ws + WS_T64);
    const bf16_t* MMT = (const bf16_t*)(p.ws + WS_MMT) + (size_t)(l * 4 + g) * 8192;
    bf16_t* MIX = (bf16_t*)(p.ws + WS_MIX);
    bf16_t* Bt = (bf16_t*)lds;
    bf16_t* XX = Bt + 64 * 136;
    __syncthreads();
    {
        const int rowi = t >> 2, cs = (t & 3) * 16;
        const unsigned uu[8] = {a.x, a.y, a.z, a.w, c2.x, c2.y, c2.z, c2.w};
        if (next >= 0) f2_load(p, next, nextcx, a, c2);
#pragma unroll
        for (int i = 0; i < 8; ++i) { Bt[(cs + 2 * i) * 136 + rowi] = (bf16_t)(uu[i] & 0xffffu); Bt[(cs + 2 * i + 1) * 136 + rowi] = (bf16_t)(uu[i] >> 16); }
    }
    __syncthreads();
    f32x4 acc[4];
#pragma unroll
    for (int n = 0; n < 4; ++n) acc[n] = (f32x4){0.f, 0.f, 0.f, 0.f};
#pragma unroll
    for (int ks = 0; ks < 4; ++ks) {
        const bf16x8 a = *(const bf16x8*)(T64 + (w * 16 + fr) * 128 + ks * 32 + fq * 8);
#pragma unroll
        for (int n = 0; n < 4; ++n) acc[n] = mfma16(a, *(const bf16x8*)(Bt + (n * 16 + fr) * 136 + ks * 32 + fq * 8), acc[n]);
    }
    {
        const int po = w & 1;
#pragma unroll
        for (int n = 0; n < 4; ++n)
#pragma unroll
            for (int j = 0; j < 4; ++j) { const int k2 = (w >> 1) * 16 + fq * 4 + j; XX[k2 * 136 + po * 64 + n * 16 + fr] = f2bf(acc[n][j]); }
    }
    __syncthreads();
    const int kt2 = w >> 1;
    f32x4 a2[2];
    a2[0] = (f32x4){0.f, 0.f, 0.f, 0.f}; a2[1] = (f32x4){0.f, 0.f, 0.f, 0.f};
#pragma unroll
    for (int ks = 0; ks < 4; ++ks) {
        const bf16x8 bx = *(const bf16x8*)(XX + (kt2 * 16 + fr) * 136 + ks * 32 + fq * 8);
#pragma unroll
        for (int ei = 0; ei < 2; ++ei) { const int et = (w & 1) * 2 + ei; a2[ei] = mfma16(*(const bf16x8*)(MMT + (et * 16 + fr) * 128 + ks * 32 + fq * 8), bx, a2[ei]); }
    }
#pragma unroll
    for (int ei = 0; ei < 2; ++ei) {
        const int et = (w & 1) * 2 + ei, k2 = kt2 * 16 + fr, e = et * 16 + fq * 4;
        const float sc = cx ? 5.656854249f : 1.f;
        u32x2 u; u.x = pk2(a2[ei].x * sc, a2[ei].y * sc); u.y = pk2(a2[ei].z * sc, a2[ei].w * sc);
        const size_t orow = cx ? (size_t)(TOKL + b * CTXL + k1 + 4 * k2) : (size_t)(b * SEQ + k1 + 128 * k2);
        *(u32x2*)(MIX + orow * DM + 512 + g * 64 + e) = u;
    }
}

DEVI void cf_item(const Params& p, int l, int item, unsigned char* lds) {
    const int t = tidx();
    const int g = item & 3, b = item >> 2;
    const bf16_t* P = (const bf16_t*)(p.ws + WS_P);
    bf16_t* YPC = (bf16_t*)(p.ws + WS_YPC);
    const int n2 = t >> 3, cg8 = (t & 7) * 8;
    float u[4][8];
#pragma unroll
    for (int n1 = 0; n1 < 4; ++n1) unpack8(*(const u32x4*)(P + (size_t)(TOKL + b * CTXL + 64 * n1 + n2) * INWP + 768 + g * 64 + cg8), u[n1]);
#pragma unroll
    for (int k1 = 0; k1 < 4; ++k1) {
        const float a = (float)(n2 * k1) * (1.f / 256.f); const float tc = __builtin_amdgcn_cosf(a), ts = __builtin_amdgcn_sinf(a);
        float pr[8], pi[8];
#pragma unroll
        for (int i = 0; i < 8; ++i) {
            float yr, yi;
            if (k1 == 0) { yr = (u[0][i] + u[2][i]) + (u[1][i] + u[3][i]); yi = 0.f; }
            else if (k1 == 1) { yr = u[0][i] - u[2][i]; yi = u[3][i] - u[1][i]; }
            else if (k1 == 2) { yr = (u[0][i] + u[2][i]) - (u[1][i] + u[3][i]); yi = 0.f; }
            else { yr = u[0][i] - u[2][i]; yi = u[1][i] - u[3][i]; }
            pr[i] = yr * tc + yi * ts; pi[i] = yi * tc - yr * ts;
        }
        bf16_t* dst = YPC + ((size_t)(((b * 4 + g) * 4 + k1) * 2)) * 4096 + n2 * 64 + cg8;
        *(u32x4*)dst = pack8(pr); *(u32x4*)(dst + 4096) = pack8(pi);
    }
}

DEVI void gla_gates16(const Params& p, int l, int row0, int h, float* gzs, float (&v)[16]) {
    const int t = tidx();
    const bf16_t* P = (const bf16_t*)(p.ws + WS_P);
    float w[16]; float bias;
    {
        const int d = t & 63, dir = (t >> 6) & 1;
        const float* wg = (dir ? p.wgb : p.wgf) + (size_t)l * 16 * 256 + h * 64 + d;
        bias = (dir ? p.bgb : p.bgf)[l * 256 + h * 64 + d];
#pragma unroll
        for (int r = 0; r < 16; ++r) w[r] = wg[r * 256];
    }
    {
        const int tok = t >> 3, sg = (t & 7) * 4;
        const u32x2 u = *(const u32x2*)(P + (size_t)(row0 + tok) * INWP + 2048 + sg);
        gzs[tok * 32 + sg + 0] = bflo(u.x); gzs[tok * 32 + sg + 1] = bfhi(u.x); gzs[tok * 32 + sg + 2] = bflo(u.y); gzs[tok * 32 + sg + 3] = bfhi(u.y);
    }
    __syncthreads();
    {
        const int dir = (t >> 6) & 1, tq = t >> 7;
#pragma unroll
        for (int i = 0; i < 16; ++i) {
            const int tok = tq * 16 + i;
            float z = bias;
#pragma unroll
            for (int r = 0; r < 16; ++r) z += gzs[tok * 32 + dir * 16 + r] * w[r];
            const float ls = fminf(z, 0.f) - __logf(1.f + __expf(-fabsf(z)));
            v[i] = ls * (1.f / 16.f);
        }
    }
    __syncthreads();
}
DEVI void gla_scan16(float (&v)[16], float* la, float* gzs) {
    const int t = tidx();
    const int d = t & 63, dir = (t >> 6) & 1, q = t >> 7;
    float* col = la + (dir * 64) * 64 + d;
    if (dir == 0) {
#pragma unroll
        for (int i = 1; i < 16; ++i) v[i] += v[i - 1];
        gzs[(q * 2 + dir) * 64 + d] = v[15];
    } else {
#pragma unroll
        for (int i = 14; i >= 0; --i) v[i] += v[i + 1];
        gzs[(q * 2 + dir) * 64 + d] = v[0];
    }
    __syncthreads();
    float off = 0.f;
#pragma unroll
    for (int qq = 0; qq < 4; ++qq) { const float tv = gzs[(qq * 2 + dir) * 64 + d]; if (dir == 0 ? (qq < q) : (qq > q)) off += tv; }
#pragma unroll
    for (int i = 0; i < 16; ++i) col[(q * 16 + i) * 64] = v[i] + off;
    __syncthreads();
}
DEVI int gla_row0(int b, int mc) { return mc < 4 ? (TOKL + b * CTXL + mc * 64) : (b * SEQ + (mc - 4) * 64); }
DEVI int gla_ci(int dir, int mc) { return dir == 0 ? mc : (mc < 4 ? 3 - mc : 135 - mc); }

DEVI void g1_item(const Params& p, int l, int item, unsigned char* lds) {
    const int t = tidx(), lane = t & 63, w = t >> 6, fr = lane & 15, fq = lane >> 4;
    const int h = item & 3, mc = (item >> 2) % NCI, b = (item >> 2) / NCI;
    const int row0 = gla_row0(b, mc);
    const bf16_t* P = (const bf16_t*)(p.ws + WS_P);
    bf16_t* UT = (bf16_t*)(p.ws + WS_UT);
    float* DEC = (float*)(p.ws + WS_DEC);
    float* la = (float*)lds;
    bf16_t* kT = (bf16_t*)(lds + 32768);
    bf16_t* vT = kT + 2 * 64 * 72;
    float* gzs = (float*)(lds + 32768 + 3 * 64 * 72 * 2);
    const u32x4 kraw = *(const u32x4*)(P + (size_t)(row0 + (t >> 3)) * INWP + 1280 + h * 64 + (t & 7) * 8);
    const u32x4 vraw = *(const u32x4*)(P + (size_t)(row0 + (t >> 3)) * INWP + 1536 + h * 64 + (t & 7) * 8);
    __syncthreads();
    {
        float lv[16];
        gla_gates16(p, l, row0, h, gzs, lv);
        bf16_t* LA = (bf16_t*)(p.ws + WS_LA) + (size_t)item * 8192 + (((t >> 6) & 1) * 64 + (t >> 7) * 16) * 64 + (t & 63);
#pragma unroll
        for (int i2 = 0; i2 < 16; ++i2) LA[i2 * 64] = f2bf(lv[i2]);
        gla_scan16(lv, la, gzs);
    }
    {
        const int s = t >> 3, seg = (t & 7) * 8;
        float kv[8], vv[8];
        unpack8(kraw, kv);
        unpack8(vraw, vv);
#pragma unroll
        for (int i = 0; i < 8; ++i) {
            const int d = seg + i;
            const float bt0 = la[63 * 64 + d], bt1 = la[64 * 64 + d];
            kT[(d) * 72 + s] = f2bf(kv[i] * __expf(bt0 - la[s * 64 + d]));
            kT[(64 + d) * 72 + s] = f2bf(kv[i] * __expf(bt1 - la[(64 + s) * 64 + d]));
            vT[d * 72 + s] = raw16(vraw, i);
        }
        if (t < 128) { const int dir = t >> 6, d = t & 63; const float bt = dir ? la[64 * 64 + d] : la[63 * 64 + d];
            DEC[((size_t)((b * 2 + dir) * NCI + gla_ci(dir, mc)) * 4 + h) * 64 + d] = __expf(bt); }
    }
    __syncthreads();
    {
        const int dir = w >> 2, mt = w & 3;
        f32x4 acc[4];
#pragma unroll
        for (int n = 0; n < 4; ++n) acc[n] = (f32x4){0.f, 0.f, 0.f, 0.f};
#pragma unroll
        for (int ks = 0; ks < 2; ++ks) {
            const bf16x8 a = *(const bf16x8*)(kT + (dir * 64 + mt * 16 + fr) * 72 + ks * 32 + fq * 8);
#pragma unroll
            for (int n = 0; n < 4; ++n) acc[n] = mfma16(a, *(const bf16x8*)(vT + (n * 16 + fr) * 72 + ks * 32 + fq * 8), acc[n]);
        }
        bf16_t* dst = UT + ((size_t)((b * 2 + dir) * NCI + gla_ci(dir, mc)) * 4 + h) * 4096;
#pragma unroll
        for (int n = 0; n < 4; ++n) { u32x2 u; u.x = pk2(acc[n].x, acc[n].y); u.y = pk2(acc[n].z, acc[n].w); *(u32x2*)(dst + (n * 16 + fr) * 64 + mt * 16 + fq * 4) = u; }
    }
}

DEVI void g2_item(const Params& p, int item) {
    const int gid = item * NT + tidx();
    const int d = gid & 63, e = (gid >> 6) & 63, h = (gid >> 12) & 3, bd = gid >> 14;
    bf16_t* u = (bf16_t*)(p.ws + WS_UT) + ((size_t)bd * NCI * 4 + h) * 4096 + e * 64 + d;
    const float* dc = (const float*)(p.ws + WS_DEC) + ((size_t)bd * NCI * 4 + h) * 64 + d;
    float s = 0.f;
    for (int c0 = 0; c0 < NCI; c0 += 33) {
        float uv[33], dv[33];
#pragma unroll
        for (int i = 0; i < 33; ++i) { uv[i] = bf2f(u[(size_t)(c0 + i) * 4 * 4096]); dv[i] = dc[(size_t)(c0 + i) * 256]; }
#pragma unroll
        for (int i = 0; i < 33; ++i) { u[(size_t)(c0 + i) * 4 * 4096] = f2bf(s); s = dv[i] * s + uv[i]; }
    }
}

struct G3Pre { u32x4 q, k, v, r; bf16_t la[16]; };
DEVI void g3_load(const Params& p, int item, G3Pre& d) {
    const int t = tidx();
    const int h = item & 3, mc = (item >> 2) % NCI, b = (item >> 2) / NCI;
    const int row0 = mc < 4 ? (TOKL + b * CTXL + mc * 64) : (b * SEQ + (mc - 4) * 64);
    const bf16_t* prow = (const bf16_t*)(p.ws + WS_P) + (size_t)(row0 + (t >> 3)) * INWP + h * 64 + (t & 7) * 8;
    d.q = *(const u32x4*)(prow + 1024); d.k = *(const u32x4*)(prow + 1280); d.v = *(const u32x4*)(prow + 1536); d.r = *(const u32x4*)(prow + 1792);
    const bf16_t* LA = (const bf16_t*)(p.ws + WS_LA) + (size_t)item * 8192 + (((t >> 6) & 1) * 64 + (t >> 7) * 16) * 64 + (t & 63);
#pragma unroll
    for (int i2 = 0; i2 < 16; ++i2) d.la[i2] = LA[i2 * 64];
}
DEVI void g3_item(const Params& p, int l, int item, unsigned char* lds, G3Pre& pre, int next) {
    const int t = tidx(), lane = t & 63, w = t >> 6, fr = lane & 15, fq = lane >> 4;
    const int h = item & 3, mc = (item >> 2) % NCI, b = (item >> 2) / NCI;
    const int row0 = gla_row0(b, mc);
    const bf16_t* P = (const bf16_t*)(p.ws + WS_P);
    const bf16_t* ST = (const bf16_t*)(p.ws + WS_UT);
    bf16_t* MIX = (bf16_t*)(p.ws + WS_MIX);
    float* la = (float*)lds;
    bf16_t* qi = (bf16_t*)(lds + 32768);
    bf16_t* ki = (bf16_t*)(lds + 51200);
    bf16_t* vT = (bf16_t*)(lds + 69632);
    bf16_t* sT = (bf16_t*)(lds + 78848);
    float* gzs = (float*)(lds + 97280);
    float* O = (float*)(lds + 105472);
    const u32x4 qraw = pre.q, kraw = pre.k, vraw = pre.v, rraw = pre.r;
    float lv[16];
#pragma unroll
    for (int i2 = 0; i2 < 16; ++i2) lv[i2] = bf2f(pre.la[i2]);
    if (next >= 0) g3_load(p, next, pre);
    __syncthreads();
    gla_scan16(lv, la, gzs);
    {
        const int s = t >> 3, seg = (t & 7) * 8;
        float qv[8], kv[8], vv[8];
        unpack8(qraw, qv);
        unpack8(kraw, kv);
        unpack8(vraw, vv);
#pragma unroll
        for (int dir = 0; dir < 2; ++dir) {
            float a[8], c[8];
#pragma unroll
            for (int i = 0; i < 8; ++i) { const float bc = la[(dir * 64 + s) * 64 + seg + i]; a[i] = qv[i] * 0.125f * __expf(bc); c[i] = kv[i] * __expf(-bc); }
            *(u32x4*)(qi + (dir * 64 + s) * 72 + seg) = pack8(a);
            *(u32x4*)(ki + (dir * 64 + s) * 72 + seg) = pack8(c);
        }
#pragma unroll
        for (int i = 0; i < 8; ++i) vT[(seg + i) * 72 + s] = raw16(vraw, i);
#pragma unroll
        for (int i = 0; i < 2; ++i) {
            const int id = i * NT + t, dir = id >> 9, e = (id >> 3) & 63, sg = (id & 7) * 8;
            const bf16_t* src = ST + ((size_t)((b * 2 + dir) * NCI + gla_ci(dir, mc)) * 4 + h) * 4096 + e * 64 + sg;
            *(u32x4*)(sT + (dir * 64 + e) * 72 + sg) = *(const u32x4*)src;
        }
    }
    __syncthreads();
    {
        const int dir = w >> 2, nt = w & 3;
        bf16x8 bq[2];
#pragma unroll
        for (int ks = 0; ks < 2; ++ks) bq[ks] = *(const bf16x8*)(qi + (dir * 64 + nt * 16 + fr) * 72 + ks * 32 + fq * 8);
        f32x4 sa[4];
#pragma unroll
        for (int m = 0; m < 4; ++m) sa[m] = (f32x4){0.f, 0.f, 0.f, 0.f};
#pragma unroll
        for (int ks = 0; ks < 2; ++ks)
#pragma unroll
            for (int m = 0; m < 4; ++m) sa[m] = mfma16(*(const bf16x8*)(ki + (dir * 64 + m * 16 + fr) * 72 + ks * 32 + fq * 8), bq[ks], sa[m]);
        const int tt = nt * 16 + fr;
#pragma unroll
        for (int m = 0; m < 4; ++m)
#pragma unroll
            for (int j = 0; j < 4; ++j) { const int s = m * 16 + fq * 4 + j; const bool keep = dir ? (s >= tt) : (s <= tt); if (!keep) sa[m][j] = 0.f; }
        f32x4 oa[4];
#pragma unroll
        for (int et = 0; et < 4; ++et) oa[et] = (f32x4){0.f, 0.f, 0.f, 0.f};
#pragma unroll
        for (int k2 = 0; k2 < 2; ++k2) {
            u32x4 u; u.x = pk2(sa[2 * k2][0], sa[2 * k2][1]); u.y = pk2(sa[2 * k2][2], sa[2 * k2][3]); u.z = pk2(sa[2 * k2 + 1][0], sa[2 * k2 + 1][1]); u.w = pk2(sa[2 * k2 + 1][2], sa[2 * k2 + 1][3]);
            const bf16x8 pb = __builtin_bit_cast(bf16x8, u);
#pragma unroll
            for (int et = 0; et < 4; ++et) {
                const bf16x4 v0 = *(const bf16x4*)(vT + (et * 16 + fr) * 72 + (2 * k2) * 16 + fq * 4);
                const bf16x4 v1 = *(const bf16x4*)(vT + (et * 16 + fr) * 72 + (2 * k2 + 1) * 16 + fq * 4);
                oa[et] = mfma16(__builtin_shufflevector(v0, v1, 0, 1, 2, 3, 4, 5, 6, 7), pb, oa[et]);
            }
        }
#pragma unroll
        for (int ks = 0; ks < 2; ++ks)
#pragma unroll
            for (int et = 0; et < 4; ++et) oa[et] = mfma16(*(const bf16x8*)(sT + (dir * 64 + et * 16 + fr) * 72 + ks * 32 + fq * 8), bq[ks], oa[et]);
#pragma unroll
        for (int et = 0; et < 4; ++et)
            *(f32x4*)(O + (dir * 64 + tt) * 68 + et * 16 + fq * 4) = oa[et];
    }
    __syncthreads();
    {
        const int tok = t >> 3, seg = (t & 7) * 8;
        float ov[8], rv[8]; float ss = 0.f;
        { const f32x4 a0 = *(const f32x4*)(O + tok * 68 + seg), a1 = *(const f32x4*)(O + tok * 68 + seg + 4), b0 = *(const f32x4*)(O + (64 + tok) * 68 + seg), b1 = *(const f32x4*)(O + (64 + tok) * 68 + seg + 4);
          const f32x4 s0 = a0 + b0, s1 = a1 + b1; ov[0] = s0.x; ov[1] = s0.y; ov[2] = s0.z; ov[3] = s0.w; ov[4] = s1.x; ov[5] = s1.y; ov[6] = s1.z; ov[7] = s1.w; }
#pragma unroll
        for (int i = 0; i < 8; ++i) ss += ov[i] * ov[i];
        ss += dpp_xor1(ss); ss += dpp_xor2(ss); ss += __shfl_xor(ss, 4);
        const float rstd = rsqrtf(ss * (1.f / 64.f) + 1e-6f);
        unpack8(rraw, rv);
#pragma unroll
        for (int i = 0; i < 8; ++i) ov[i] = ov[i] * rstd * p.glag[l * 64 + seg + i] * silu_f(rv[i]);
        *(u32x4*)(MIX + (size_t)(row0 + tok) * DM + 768 + h * 64 + seg) = pack8(ov);
    }
}

constexpr int NPH = 19;
DEVI void run_phase(const Params& p, int ph, unsigned char* lds) {
    if (ph == 0) { prep_phase(p, lds); return; }
    const int l = (ph - 1) / 9, s = (ph - 1) % 9;
    const bool last = (l == 1);
    const float* MOD = (const float*)(p.ws + WS_MOD) + l * 3 * 6144;
    bf16_t* H = (bf16_t*)(p.ws + WS_H);
    float* XC = (float*)(p.ws + WS_XC);
    switch (s) {
    case 0: norm_phase(p, l, 0); break;
    case 1: { EpiInProj e{(bf16_t*)(p.ws + WS_P), (bf16_t*)(p.ws + WS_VTL), (bf16_t*)(p.ws + WS_VTC)};
              gemm_phase8(H, (const bf16_t*)(p.ws + WS_WIN + l * SZ_WIN), DM, 66, 9, e, lds);
              {
                  const int G = gridDim.x, rem = (66 * 9) % G, first = rem ? rem : 0, nidle = G - first;
                  if ((int)blockIdx.x >= first) prep_phase(p, lds, l == 0 ? 1 : 2, first, nidle);
              } } break;
    case 2: {
        const int nA = last ? 256 : 264, nCF = last ? 0 : 8, nF1 = 512, nG1 = 2 * NCI * 4;
        const int G = gridDim.x;
        { const float* rt = (const float*)(p.ws + WS_ROPE); float* rl = (float*)(lds + ROPE_LDS_OFF); for (int i = tidx(); i < 4096; i += NT) rl[i] = rt[i]; }
        for (int it = blockIdx.x; it < nA; it += G) attn_item(p, l, it, lds);
        for (int it = (blockIdx.x + G - (nA % G)) % G; it < nCF; it += G) cf_item(p, l, it, lds);
        int g1s, g1n, gstep = 1, f1a = 0, f1n = 0, f1x = -1, fstep = 1;
        const int bx = blockIdx.x;
        if (G == 256) {
            if (!last) {
                if (bx < 8) { g1s = 3 * bx; g1n = 3; f1a = bx; f1n = 1; }
                else if (bx < 16) { g1s = 24 + 4 * (bx - 8); g1n = 4; f1a = bx; f1n = 1; }
                else if (bx < 56) { g1s = 56 + 5 * (bx - 16); g1n = 5; }
                else { g1s = 256 + 4 * (bx - 56); g1n = 4; f1a = 16 + 2 * (bx - 56); f1n = 2; if (bx < 152) f1x = 416 + (bx - 56); }
            } else {
                if (bx < 32) { g1s = 5 * bx; g1n = 5; }
                else { g1s = 160 + 4 * (bx - 32); g1n = 4; f1a = 2 * (bx - 32); f1n = 2; if (bx < 96) f1x = 448 + (bx - 32); }
            }
        } else {
            f1a = (bx + G - ((nA + nCF) % G)) % G; fstep = G; f1n = f1a < nF1 ? (nF1 - 1 - f1a) / G + 1 : 0;
            g1s = (bx + G - ((nA + nCF + nF1) % G)) % G; gstep = G; g1n = g1s < nG1 ? (nG1 - 1 - g1s) / G + 1 : 0;
        }
        {
            const int ftot = f1n + (f1x >= 0 ? 1 : 0);
            u32x4 fa, fc;
            if (ftot > 0) f1_load(p, f1a, fa, fc);
            for (int j = 0; j < ftot; ++j) {
                const int cur = j < f1n ? f1a + j * fstep : f1x;
                const int nxt = j + 1 < f1n ? f1a + (j + 1) * fstep : (j + 1 < ftot ? f1x : -1);
                f1_item(p, cur, lds, fa, fc, nxt);
            }
        }
        for (int j = 0; j < g1n; ++j) g1_item(p, l, g1s + j * gstep, lds);
    } break;
    case 3: {
        const int nG2 = 128, nF2 = 1024, nF2c = last ? 0 : 32;
        const int G = gridDim.x;
        for (int it = blockIdx.x; it < nG2; it += G) g2_item(p, it);
        if (G == 256) {
            const int bx = blockIdx.x;
            const int first = bx < 128 ? bx * 2 : 256 + (bx - 128) * 6, cnt = bx < 128 ? 2 : 6;
            const bool hasc = bx >= 128 && (bx - 128) < nF2c;
            u32x4 fa, fc; f2_load(p, first, false, fa, fc);
            for (int j = 0; j < cnt; ++j) { const bool lastj = j + 1 == cnt; f2_item(p, l, first + j, lds, false, fa, fc, lastj ? (hasc ? bx - 128 : -1) : first + j + 1, lastj && hasc); }
            if (hasc) f2_item(p, l, bx - 128, lds, true, fa, fc, -1, false);
        } else {
            u32x4 fa, fc;
            for (int it = blockIdx.x; it < nF2; it += G) { f2_load(p, it, false, fa, fc); f2_item(p, l, it, lds, false, fa, fc, -1, false); }
            for (int it = blockIdx.x; it < nF2c; it += G) { f2_load(p, it, true, fa, fc); f2_item(p, l, it, lds, true, fa, fc, -1, false); }
        }
    } break;
    case 4: {
        const int nG3 = 2 * NCI * 4;
        {
            const int G = gridDim.x;
            auto nxt = [&](int it) { for (it += G; it < nG3; it += G) { if (!(last && ((it >> 2) % NCI) < 4)) return it; } return -1; };
            int it = (int)blockIdx.x - G; it = nxt(it);
            G3Pre pre;
            if (it >= 0) g3_load(p, it, pre);
            while (it >= 0) { const int nx = nxt(it); g3_item(p, l, it, lds, pre, nx); it = nx; }
        }
    } break;
    case 5: { EpiResid e{l == 0 ? p.x : p.out, l == 0 ? p.ctx : XC, p.out, XC, MOD, 2 * DM, (float*)(p.ws + WS_PART)};
              gemm_phase8((const bf16_t*)(p.ws + WS_MIX), (const bf16_t*)(p.ws + WS_WOUT + l * SZ_WOUT), DM, 64, 4, e, lds, last ? 0 : 4); } break;
    case 6: norm_phase(p, l, 1); break;
    case 7: { EpiSwiglu e{(bf16_t*)(p.ws + WS_HID)};
              gemm_phase8(H, (const bf16_t*)(p.ws + WS_WFI + l * SZ_WFI), DM, last ? 64 : 66, 22, e, lds); } break;
    case 8: { EpiResid e{p.out, XC, p.out, XC, MOD, 5 * DM, (float*)(p.ws + WS_PART)};
              gemm_phase8((const bf16_t*)(p.ws + WS_HID), (const bf16_t*)(p.ws + WS_WFO + l * SZ_WFO), FFH, 64, 4, e, lds, last ? 0 : 4); } break;
    }
}


#define XB_TMO      128
#define XB_XCNT(j)  (256  + 64 * (j))
#define XB_XSUB(j)  (1280 + 64 * (j))
#define XB_XGEN(j)  (2304 + 64 * (j))
#define XB_TOP      3328
#define XB_TOPGEN   3392
#define XCD_BAR_WORDS 3456
#define XB_SPIN_CAP (1u << 18)
DEVI unsigned xb_ld(unsigned* p) { return __hip_atomic_load(p, __ATOMIC_RELAXED, __HIP_MEMORY_SCOPE_AGENT); }
DEVI unsigned xb_add(unsigned* p, unsigned v) { return __hip_atomic_fetch_add(p, v, __ATOMIC_RELAXED, __HIP_MEMORY_SCOPE_AGENT); }
DEVI unsigned xb_xcc_id() { return (unsigned)__builtin_amdgcn_s_getreg((3 << 11) | 20) & 0xFu; }
#define XB_SPIN(cond, bar) do { unsigned _sp = 0; while (cond) { __builtin_amdgcn_s_sleep(1); \
    if ((++_sp & 255u) == 0u) { if (xb_ld(&(bar)[XB_TMO])) break; if (_sp > XB_SPIN_CAP) { atomicAdd(&(bar)[XB_TMO], 1u); break; } } } } while (0)
struct XcdBarrier { unsigned* bar; unsigned x; volatile __attribute__((address_space(3))) unsigned* st; };
DEVI XcdBarrier xcd_barrier_post(unsigned* bar, volatile __attribute__((address_space(3))) unsigned* st) {
    XcdBarrier b; b.bar = bar; b.x = xb_xcc_id(); b.st = st;
    if (threadIdx.x == 0) (void)xb_add(&bar[XB_XCNT(b.x)], 1u);
    return b;
}
DEVI void xcd_barrier_complete(unsigned* bar, unsigned x, unsigned& nloc, unsigned& nx) {
    const unsigned G = gridDim.x * gridDim.y * gridDim.z;
    unsigned sum, cnt, mine, sp = 0u;
    for (;;) {
        sum = 0u; cnt = 0u; mine = 0u;
#pragma unroll
        for (unsigned j = 0; j < 16; ++j) { const unsigned c = xb_ld(&bar[XB_XCNT(j)]); sum += c; cnt += (c > 0u) ? 1u : 0u; mine = (j == x) ? c : mine; }
        if (sum == G) break;
        __builtin_amdgcn_s_sleep(1);
        if ((++sp & 255u) == 0u) { if (xb_ld(&bar[XB_TMO])) break; if (sp > XB_SPIN_CAP) { atomicAdd(&bar[XB_TMO], 1u); break; } }
    }
    nloc = mine > 0u ? mine : 1u; nx = cnt > 0u ? cnt : 1u;
}
DEVI void xcd_barrier(const XcdBarrier& b) {
    asm volatile("s_waitcnt vmcnt(0)" ::: "memory");
    __syncthreads();
    if (threadIdx.x == 0) {
        unsigned* bar = b.bar;
        __builtin_amdgcn_s_waitcnt(0);
        unsigned nloc = b.st[0], nx = b.st[1];
        if (nloc == 0u) { xcd_barrier_complete(bar, b.x, nloc, nx); b.st[0] = nloc; b.st[1] = nx; }
        const unsigned old = xb_add(&bar[XB_XSUB(b.x)], 1u);
        const unsigned gen = old / nloc;
        if (old + 1u == (gen + 1u) * nloc) {
            __builtin_amdgcn_fence(__ATOMIC_RELEASE, "agent");
            asm volatile("s_waitcnt vmcnt(0)" ::: "memory");
            const unsigned og = xb_add(&bar[XB_TOP], 1u);
            const unsigned tg = og / nx;
            if (og + 1u == (tg + 1u) * nx) xb_add(&bar[XB_TOPGEN], 1u);
            else XB_SPIN(xb_ld(&bar[XB_TOPGEN]) == tg, bar);
            __builtin_amdgcn_fence(__ATOMIC_ACQUIRE, "agent");
            xb_add(&bar[XB_XGEN(b.x)], 1u);
            asm volatile("s_waitcnt vmcnt(0)" ::: "memory");
        } else {
            XB_SPIN(xb_ld(&bar[XB_XGEN(b.x)]) == gen, bar);
            __builtin_amdgcn_fence(__ATOMIC_ACQUIRE, "agent");
            asm volatile("s_waitcnt vmcnt(0)" ::: "memory");
        }
    }
    __syncthreads();
}

__global__ void __launch_bounds__(NT) mega_fwd(Params p) {
    extern __shared__ __attribute__((aligned(16))) unsigned char lds[];
    cg::grid_group grid = cg::this_grid();
    typedef const __attribute__((address_space(4))) Params* kparams_t;
    volatile __attribute__((address_space(3))) unsigned* xst = (volatile __attribute__((address_space(3))) unsigned*)((__attribute__((address_space(3))) unsigned char*)lds + (LDS_BYTES - 16));
    if (threadIdx.x == 0) { xst[0] = 0u; xst[1] = 0u; }
    __syncthreads();
    const bool fused = (p.ph_hi - p.ph_lo) > 1;
    XcdBarrier xb; xb.bar = (unsigned*)(p.ws + WS_BAR); xb.x = 0; xb.st = xst;
    if (fused) xb = xcd_barrier_post((unsigned*)(p.ws + WS_BAR), xst);
    for (int ph = p.ph_lo; ph < p.ph_hi; ++ph) {
        if (ph > p.ph_lo) { if (p.ph_lo < 0) grid.sync(); else xcd_barrier(xb); }
#if defined(__HIP_DEVICE_COMPILE__)
        kparams_t kp = (kparams_t)__builtin_amdgcn_kernarg_segment_ptr();
        asm volatile("" : "+s"(kp));
        Params lp;
        { const __attribute__((address_space(4))) unsigned long long* s8 = (const __attribute__((address_space(4))) unsigned long long*)kp; unsigned long long* d8 = (unsigned long long*)&lp;
#pragma unroll
          for (int i = 0; i < (int)(sizeof(Params) / 8); ++i) d8[i] = s8[i]; }
        run_phase(lp, ph, lds);
#endif
    }
}

extern "C" void kernel_launch(void* const* d_in, const int* in_sizes, int n_in, void* d_out, int out_size, void* d_ws, size_t ws_size, hipStream_t stream) {
    static int grid = 0;
    if (grid == 0) {
        if (ws_size < WS_TOTAL) { fprintf(stderr, "kernel_launch: workspace too small (%zu < %zu)\n", ws_size, (size_t)WS_TOTAL); grid = -1; return; }
        int dev = 0, cus = 0, per_cu = 0;
        hipGetDevice(&dev);
        hipDeviceGetAttribute(&cus, hipDeviceAttributeMultiprocessorCount, dev);
        if (hipFuncSetAttribute((const void*)mega_fwd, hipFuncAttributeMaxDynamicSharedMemorySize, LDS_BYTES) != hipSuccess) fprintf(stderr, "kernel_launch: hipFuncSetAttribute failed\n");
        if (hipOccupancyMaxActiveBlocksPerMultiprocessor(&per_cu, (const void*)mega_fwd, NT, LDS_BYTES) != hipSuccess || per_cu < 1) { fprintf(stderr, "kernel_launch: occupancy query gave %d\n", per_cu); per_cu = 1; }
        (void)hipGetLastError();
        grid = cus * per_cu;
        fprintf(stderr, "kernel_launch: grid %d (cus %d x %d)\n", grid, cus, per_cu);
    }
    if (grid < 0) return;
    (void)hipMemsetAsync((unsigned char*)d_ws + WS_BAR, 0, 16384, stream);
    Params p{};
    const float** f = (const float**)&p;
    for (int i = 0; i < 21; ++i) f[i] = (const float*)d_in[i];
    p.out = (float*)d_out; p.ws = (unsigned char*)d_ws;
#if N_LAUNCH_SPLIT
    for (int ph = 0; ph < NPH; ++ph) { p.ph_lo = ph; p.ph_hi = ph + 1; hipLaunchKernelGGL(mega_fwd, dim3(grid), dim3(NT), LDS_BYTES, stream, p); }
#else
    p.ph_lo = 0; p.ph_hi = NPH;
    void* args[] = {&p};
    hipError_t e = hipLaunchCooperativeKernel((const void*)mega_fwd, dim3(grid), dim3(NT), args, LDS_BYTES, stream);
    if (e != hipSuccess) fprintf(stderr, "kernel_launch: cooperative launch failed: %s (grid %d)\n", hipGetErrorString(e), grid);
#endif
}
```

```cpp
#include <hip/hip_runtime.h>
#include <hip/hip_cooperative_groups.h>
#include <cstdio>
#include <cstdint>
namespace cg = cooperative_groups;

typedef unsigned short bf16_t;
typedef short bf16x8 __attribute__((ext_vector_type(8)));
typedef short bf16x4 __attribute__((ext_vector_type(4)));
typedef float f32x4 __attribute__((ext_vector_type(4)));
typedef unsigned u32x4 __attribute__((ext_vector_type(4)));
typedef unsigned u32x2 __attribute__((ext_vector_type(2)));

#define DEVI __device__ __forceinline__
#ifndef N_LAUNCH_SPLIT
#define N_LAUNCH_SPLIT 0
#endif

constexpr int NT = 512;
constexpr int DM = 1024, SEQ = 8192, CTXL = 256;
constexpr int TOKL = 16384, TOKC = 512, TOK = 16896;
constexpr int INW = 2080, INWP = 2304, FFH = 2816;
constexpr int NCI = 132;
constexpr int LDS_BYTES = 147456;

constexpr size_t SZ_WIN = (size_t)INWP * DM * 2, SZ_WOUT = (size_t)DM * DM * 2, SZ_WFI = (size_t)2 * FFH * DM * 2, SZ_WFO = (size_t)DM * FFH * 2;
constexpr size_t WS_WIN = 0;
constexpr size_t WS_WOUT = WS_WIN + 2 * SZ_WIN;
constexpr size_t WS_WFI = WS_WOUT + 2 * SZ_WOUT;
constexpr size_t WS_WFO = WS_WFI + 2 * SZ_WFI;
constexpr size_t WS_MOD = WS_WFO + 2 * SZ_WFO;
constexpr size_t WS_ROPE = WS_MOD + 2 * 3 * 6144 * 4;
constexpr size_t WS_D128 = WS_ROPE + 2 * 128 * 16 * 4;
constexpr size_t WS_T64 = WS_D128 + 256 * 128 * 2;
constexpr size_t WS_MMT = WS_T64 + 128 * 128 * 2;
constexpr size_t WS_XC = WS_MMT + 2 * 4 * 64 * 128 * 2;
constexpr size_t WS_DEC = WS_XC + (size_t)TOKC * DM * 4;
constexpr size_t WS_H = WS_DEC + (size_t)2 * 2 * NCI * 4 * 64 * 4;
constexpr size_t WS_MIX = WS_H + (size_t)TOK * DM * 2;
constexpr size_t WS_P = WS_MIX + (size_t)TOK * DM * 2;
constexpr size_t WS_VTL = WS_P + (size_t)TOK * INWP * 2;
constexpr size_t WS_VTC = WS_VTL + (size_t)2 * 2 * 64 * SEQ * 2;
constexpr size_t WS_YP = WS_VTC + (size_t)2 * 2 * 64 * CTXL * 2;
constexpr size_t WS_UT = WS_YP + (size_t)2 * 4 * 128 * 2 * 64 * 64 * 2;
constexpr size_t WS_END = WS_UT + (size_t)2 * 2 * NCI * 4 * 4096 * 2;
constexpr size_t WS_BAR = WS_END;
constexpr size_t WS_PART = WS_BAR + 16384;
constexpr size_t WS_YPC = WS_PART + (size_t)4 * TOKC * DM * 4;
constexpr size_t WS_LA = WS_YPC + (size_t)2 * 4 * 4 * 2 * 64 * 64 * 2;
constexpr size_t WS_TOTAL = WS_LA + (size_t)2 * NCI * 4 * 2 * 64 * 64 * 2;
constexpr size_t WS_HID = WS_P;
static_assert(WS_HID + (size_t)TOK * FFH * 2 <= WS_UT, "HID overlay");
static_assert(WS_TOTAL <= 268435456ull, "workspace");

struct Params {
    const float *x, *c, *ctx, *c_ctx, *w_mod, *b_mod, *g1, *w_in, *qg, *kg, *sink, *wf, *wgf, *bgf, *wgb, *bgb, *glag, *w_out, *g2, *w_fi, *w_fo;
    float* out; unsigned char* ws;
    int ph_lo, ph_hi;
};

DEVI int tidx() { int t = threadIdx.x; asm volatile("" : "+v"(t)); return t; }
typedef __bf16 bf16v2 __attribute__((ext_vector_type(2)));
DEVI unsigned pk2(float lo, float hi) { bf16v2 v = {(__bf16)lo, (__bf16)hi}; return __builtin_bit_cast(unsigned, v); }
DEVI bf16_t f2bf(float f) { return (bf16_t)(pk2(f, 0.f) & 0xffffu); }
DEVI float bf2f(bf16_t h) { return __uint_as_float(((unsigned)h) << 16); }
DEVI float bflo(unsigned u) { return __uint_as_float(u << 16); }
DEVI float bfhi(unsigned u) { return __uint_as_float(u & 0xffff0000u); }
DEVI f32x4 mfma16(bf16x8 a, bf16x8 b, f32x4 c) { return __builtin_amdgcn_mfma_f32_16x16x32_bf16(a, b, c, 0, 0, 0); }
DEVI void unpack8(u32x4 u, float* v) { v[0] = bflo(u.x); v[1] = bfhi(u.x); v[2] = bflo(u.y); v[3] = bfhi(u.y); v[4] = bflo(u.z); v[5] = bfhi(u.z); v[6] = bflo(u.w); v[7] = bfhi(u.w); }
DEVI u32x4 pack8(const float* v) { u32x4 o; o.x = pk2(v[0], v[1]); o.y = pk2(v[2], v[3]); o.z = pk2(v[4], v[5]); o.w = pk2(v[6], v[7]); return o; }
DEVI float dpp_xor1(float x) { return __uint_as_float((unsigned)__builtin_amdgcn_mov_dpp((int)__float_as_uint(x), 0xB1, 0xF, 0xF, true)); }
DEVI float dpp_xor2(float x) { return __uint_as_float((unsigned)__builtin_amdgcn_mov_dpp((int)__float_as_uint(x), 0x4E, 0xF, 0xF, true)); }
DEVI float red_max_16_32(float x) {
    auto r = __builtin_amdgcn_permlane16_swap(__float_as_uint(x), __float_as_uint(x), false, false); x = fmaxf(__uint_as_float(r[0]), __uint_as_float(r[1]));
    auto q = __builtin_amdgcn_permlane32_swap(__float_as_uint(x), __float_as_uint(x), false, false); return fmaxf(__uint_as_float(q[0]), __uint_as_float(q[1]));
}
DEVI float red_sum_16_32(float x) {
    auto r = __builtin_amdgcn_permlane16_swap(__float_as_uint(x), __float_as_uint(x), false, false); x = __uint_as_float(r[0]) + __uint_as_float(r[1]);
    auto q = __builtin_amdgcn_permlane32_swap(__float_as_uint(x), __float_as_uint(x), false, false); return __uint_as_float(q[0]) + __uint_as_float(q[1]);
}
DEVI bf16_t raw16(const u32x4 u, int i) { const unsigned w = (i >> 1) == 0 ? u.x : ((i >> 1) == 1 ? u.y : ((i >> 1) == 2 ? u.z : u.w)); return (bf16_t)((i & 1) ? (w >> 16) : (w & 0xffffu)); }
DEVI float silu_f(float v) { return v * __builtin_amdgcn_rcpf(1.f + __builtin_amdgcn_exp2f(v * -1.44269504f)); }

DEVI void transpose_tile(const float* __restrict__ W, int N, int Nvalid, bf16_t* __restrict__ WT, int Kdst, int k0, int n0, int mode, float* tile) {
    const int t = tidx();
    __syncthreads();
    {
        const int c4 = (t & 63) * 4;
        float4 v[8];
#pragma unroll
        for (int i = 0; i < 8; ++i) { const int kk = (t >> 6) + 8 * i; v[i] = make_float4(0.f, 0.f, 0.f, 0.f); if (n0 + c4 < Nvalid) v[i] = *(const float4*)(W + (size_t)(k0 + kk) * N + n0 + c4); }
#pragma unroll
        for (int i = 0; i < 8; ++i) { const int kk = (t >> 6) + 8 * i; tile[kk * 257 + c4 + 0] = v[i].x; tile[kk * 257 + c4 + 1] = v[i].y; tile[kk * 257 + c4 + 2] = v[i].z; tile[kk * 257 + c4 + 3] = v[i].w; }
    }
    __syncthreads();
    const int nn = t >> 1, ks = (t & 1) * 32;
    const int n = n0 + nn;
    int orow = n;
    if (mode == 1) { if (n < FFH) orow = (n >> 7) * 256 + (n & 127); else { const int j = n - FFH; orow = (j >> 7) * 256 + 128 + (j & 127); } }
    { const int q5 = orow & 31; orow = (orow & ~31) + ((q5 >> 2) & 1) * 16 + (q5 >> 3) * 4 + (q5 & 3); }
#pragma unroll
    for (int q = 0; q < 4; ++q) {
        float v[8];
#pragma unroll
        for (int j = 0; j < 8; ++j) v[j] = tile[(ks + q * 8 + j) * 257 + nn];
        *(u32x4*)(WT + (size_t)orow * Kdst + k0 + ks + q * 8) = pack8(v);
    }
}

DEVI void prep_phase(const Params& p, unsigned char* lds, const int lsel = 0, const int bid0 = 0, const int nblk = 0) {
    const int t = tidx();
    constexpr int PER_L = 144 + 64 + 352 + 176;
    constexpr int N_MOD = 192, N_TAB = 9;
    const int NITEMS = N_MOD + N_TAB + (lsel == 0 ? 208 : (lsel == 1 ? 736 : 528));
    float* fl = (float*)lds;
    const int it0 = lsel ? N_MOD + N_TAB + ((int)blockIdx.x - bid0) : (int)blockIdx.x, itstep = lsel ? nblk : (int)gridDim.x;
    for (int it = it0; it < NITEMS; it += itstep) {
        if (it < N_MOD) {
            const int l = it / 96, j0 = (it % 96) * 64;
            float* sc = fl; float* red = fl + 3072;
            __syncthreads();
            for (int i = t; i < 3072; i += NT) { const int v = i >> 10, k = i & 1023; const float cv = v < 2 ? p.c[v * 1024 + k] : p.c_ctx[k]; sc[i] = cv / (1.f + expf(-cv)); }
            __syncthreads();
            const int jj = t & 63, kg = t >> 6;
            const float* w = p.w_mod + (size_t)l * 1024 * 6144 + j0 + jj;
            float a0 = 0.f, a1 = 0.f, a2 = 0.f;
#pragma unroll 1
            for (int k0 = kg * 128; k0 < kg * 128 + 128; k0 += 32) {
                float wv[32];
#pragma unroll
                for (int i = 0; i < 32; ++i) wv[i] = w[(size_t)(k0 + i) * 6144];
#pragma unroll
                for (int i = 0; i < 32; ++i) { a0 += sc[k0 + i] * wv[i]; a1 += sc[1024 + k0 + i] * wv[i]; a2 += sc[2048 + k0 + i] * wv[i]; }
            }
            red[(kg * 3 + 0) * 64 + jj] = a0; red[(kg * 3 + 1) * 64 + jj] = a1; red[(kg * 3 + 2) * 64 + jj] = a2;
            __syncthreads();
            if (t < 192) {
                const int v = t >> 6, j = t & 63; float s = 0.f;
#pragma unroll
                for (int g = 0; g < 8; ++g) s += red[(g * 3 + v) * 64 + j];
                ((float*)(p.ws + WS_MOD))[(l * 3 + v) * 6144 + j0 + j] = s + p.b_mod[l * 6144 + j0 + j];
            }
        } else if (it < N_MOD + N_TAB) {
            const int ti = it - N_MOD;
            if (ti == 0) {
                float* rope = (float*)(p.ws + WS_ROPE);
                for (int i = t; i < 128 * 16; i += NT) { const int pos = i >> 4, f = i & 15; const float inv = powf(10000.f, -(float)(2 * f) / 32.f); const float ang = (float)pos * inv; rope[i] = cosf(ang); rope[2048 + i] = sinf(ang); }
                bf16_t* d128 = (bf16_t*)(p.ws + WS_D128);
                for (int i = t; i < 256 * 128; i += NT) { const int r = i >> 7, n1 = i & 127; const int part = (r >> 4) & 1, k1 = (r >> 5) * 16 + (r & 15); const int m = (n1 * k1) & 127; const float a = (float)m / 64.f; d128[i] = f2bf(part == 0 ? cospif(a) : -sinpif(a)); }
                bf16_t* t64 = (bf16_t*)(p.ws + WS_T64);
                for (int i = t; i < 128 * 128; i += NT) { const int r = i >> 7, kk = i & 127; const int mt = r >> 4, po = mt & 1, k2 = (mt >> 1) * 16 + (r & 15), part = kk >> 6, n2 = kk & 63; const int m = (n2 * k2) & 63; const float a = (float)m / 32.f; const float cs = cospif(a), sn = sinpif(a);
                    t64[i] = f2bf(po == 0 ? (part == 0 ? cs : sn) : (part == 0 ? -sn : cs)); }
            } else {
                const int l = (ti - 1) >> 2, g = (ti - 1) & 3;
                const float* wf = p.wf + (size_t)(l * 4 + g) * 4096;
                bf16_t* mmt = (bf16_t*)(p.ws + WS_MMT) + (size_t)(l * 4 + g) * 8192;
                const float nrm = 1.0f / sqrtf(8192.f * 64.f);
                __syncthreads();
                if (t < 64) { fl[t] = cospif((float)t / 32.f); fl[64 + t] = sinpif((float)t / 32.f); }
                for (int i = t; i < 4096; i += NT) fl[128 + i] = wf[i];
                __syncthreads();
                for (int i = t; i < 8192; i += NT) { const int e = i >> 7, cp = i & 127, part = cp >> 6, c = cp & 63; float s = 0.f;
#pragma unroll 8
                    for (int e0 = 0; e0 < 64; ++e0) s += fl[part * 64 + ((c * e0) & 63)] * fl[128 + e0 * 64 + e];
                    mmt[i] = f2bf(s * nrm); }
            }
        } else {
            int r = it - N_MOD - N_TAB; int l = 0;
            if (lsel == 1) { if (r < 528) r += 208; else { r -= 528; l = 1; } }
            else if (lsel == 2) { r += 208; l = 1; }
            if (r < 144) { transpose_tile(p.w_in + (size_t)l * DM * INW, INW, INW, (bf16_t*)(p.ws + WS_WIN + l * SZ_WIN), DM, (r / 9) * 64, (r % 9) * 256, 0, fl); continue; } r -= 144;
            if (r < 64) { transpose_tile(p.w_out + (size_t)l * DM * DM, DM, DM, (bf16_t*)(p.ws + WS_WOUT + l * SZ_WOUT), DM, (r / 4) * 64, (r % 4) * 256, 0, fl); continue; } r -= 64;
            if (r < 352) { transpose_tile(p.w_fi + (size_t)l * DM * 2 * FFH, 2 * FFH, 2 * FFH, (bf16_t*)(p.ws + WS_WFI + l * SZ_WFI), DM, (r / 22) * 64, (r % 22) * 256, 1, fl); continue; } r -= 352;
            transpose_tile(p.w_fo + (size_t)l * FFH * DM, DM, DM, (bf16_t*)(p.ws + WS_WFO + l * SZ_WFO), FFH, (r / 4) * 64, (r % 4) * 256, 0, fl);
        }
    }
}

DEVI void norm_phase(const Params& p, int l, int which) {
    const int lane = tidx() & 63, wave = tidx() >> 6;
    const int nrows = (which == 1 && l == 1) ? TOKL : TOK;
    const float* MOD = (const float*)(p.ws + WS_MOD);
    const float* XC = (const float*)(p.ws + WS_XC);
    bf16_t* H = (bf16_t*)(p.ws + WS_H);
    const float* g = (which ? p.g2 : p.g1) + l * DM;
    for (int r = blockIdx.x * 8 + wave; r < nrows; r += gridDim.x * 8) {
        const float* src; int vec;
        if (r < TOKL) { src = ((which == 0 && l == 0) ? p.x : p.out) + (size_t)r * DM; vec = r >> 13; }
        else { const int rc = r - TOKL; src = ((which == 0 && l == 0) ? p.ctx : XC) + (size_t)rc * DM; vec = 2; }
        const float* mod = MOD + (l * 3 + vec) * 6144;
        const float* sh = mod + (which ? 3 * DM : 0);
        const float* sc = mod + (which ? 4 * DM : DM);
        f32x4 v[4]; float ss = 0.f;
        const bool fold = (r >= TOKL) && ((which == 1 && l == 0) || (which == 0 && l == 1));
#pragma unroll
        for (int j = 0; j < 4; ++j) {
            v[j] = *(const f32x4*)(src + j * 256 + lane * 4);
            if (fold) {
                const float* pb = (const float*)(p.ws + WS_PART) + (size_t)(r - TOKL) * DM + j * 256 + lane * 4;
#pragma unroll
                for (int s = 0; s < 4; ++s) v[j] += *(const f32x4*)(pb + (size_t)s * TOKC * DM);
                *(f32x4*)((float*)(p.ws + WS_XC) + (size_t)(r - TOKL) * DM + j * 256 + lane * 4) = v[j];
            }
            ss += v[j].x * v[j].x + v[j].y * v[j].y + v[j].z * v[j].z + v[j].w * v[j].w;
        }
#pragma unroll
        for (int o = 1; o < 64; o <<= 1) ss += __shfl_xor(ss, o);
        const float rstd = rsqrtf(ss * (1.f / DM) + 1e-6f);
#pragma unroll
        for (int j = 0; j < 4; ++j) {
            const int k = j * 256 + lane * 4;
            const f32x4 gv = *(const f32x4*)(g + k), sv = *(const f32x4*)(sc + k), hv = *(const f32x4*)(sh + k);
            const f32x4 y = (v[j] * rstd) * gv * (sv + 1.f) + hv;
            u32x2 o; o.x = pk2(y.x, y.y); o.y = pk2(y.z, y.w);
            *(u32x2*)(H + (size_t)r * DM + k) = o;
            if (which == 0 && l == 0 && r >= TOKL) *(f32x4*)((float*)(p.ws + WS_XC) + (size_t)(r - TOKL) * DM + k) = v[j];
        }
    }
}

template <class Epi>
DEVI void gemm_phase(const bf16_t* __restrict__ A, const bf16_t* __restrict__ Bt, int K, int nM, int nN, const Epi& epi, unsigned char* lds) {
    bf16_t* As = (bf16_t*)lds; bf16_t* Bs = As + 256 * 72;
    const int t = tidx(), lane = t & 63, wid = t >> 6, wr = wid >> 2, wc = wid & 3, fr = lane & 15, fq = lane >> 4;
    const int ntile = nM * nN;
    for (int tile = blockIdx.x; tile < ntile; tile += gridDim.x) {
        const int pm = tile / nN, pn = tile % nN;
        f32x4 acc[2][2][4][2];
#pragma unroll
        for (int ai = 0; ai < 2; ++ai)
#pragma unroll
            for (int bj = 0; bj < 2; ++bj)
#pragma unroll
                for (int m = 0; m < 4; ++m)
#pragma unroll
                    for (int n = 0; n < 2; ++n) acc[ai][bj][m][n] = (f32x4){0.f, 0.f, 0.f, 0.f};
        const bf16_t* Ab = A + (size_t)pm * 256 * K; const bf16_t* Bb = Bt + (size_t)pn * 256 * K;
        for (int k0 = 0; k0 < K; k0 += 64) {
            u32x4 ra[4], rb[4];
#pragma unroll
            for (int i = 0; i < 4; ++i) { const int id = i * NT + t, row = id >> 3, seg = id & 7; ra[i] = *(const u32x4*)(Ab + (size_t)row * K + k0 + seg * 8); rb[i] = *(const u32x4*)(Bb + (size_t)row * K + k0 + seg * 8); }
            __syncthreads();
#pragma unroll
            for (int i = 0; i < 4; ++i) { const int id = i * NT + t, row = id >> 3, seg = id & 7; *(u32x4*)(As + row * 72 + seg * 8) = ra[i]; *(u32x4*)(Bs + row * 72 + seg * 8) = rb[i]; }
            __syncthreads();
#pragma unroll
            for (int ks = 0; ks < 2; ++ks) {
                bf16x8 af[2][4], bfg[2][2];
#pragma unroll
                for (int ai = 0; ai < 2; ++ai)
#pragma unroll
                    for (int m = 0; m < 4; ++m) af[ai][m] = *(const bf16x8*)(As + (ai * 128 + wr * 64 + m * 16 + fr) * 72 + ks * 32 + fq * 8);
#pragma unroll
                for (int bj = 0; bj < 2; ++bj)
#pragma unroll
                    for (int n = 0; n < 2; ++n) bfg[bj][n] = *(const bf16x8*)(Bs + (bj * 128 + wc * 32 + n * 16 + fr) * 72 + ks * 32 + fq * 8);
#pragma unroll
                for (int ai = 0; ai < 2; ++ai)
#pragma unroll
                    for (int bj = 0; bj < 2; ++bj)
#pragma unroll
                        for (int m = 0; m < 4; ++m)
#pragma unroll
                            for (int n = 0; n < 2; ++n) acc[ai][bj][m][n] = mfma16(bfg[bj][n], af[ai][m], acc[ai][bj][m][n]);
            }
        }
        epi(acc, pm, pn, wr, wc, fr, fq);
    }
}


typedef __attribute__((address_space(3))) unsigned char ldsb_t;
typedef __attribute__((address_space(3))) unsigned ldsu_t;
DEVI int g8_lds_byte(int r, int c) { const int st = (r >> 4) * 2 + (c >> 5), rr = r & 15, cc = c & 31, ob = rr * 64 + cc * 2; return st * 1024 + (ob ^ (((ob >> 9) & 1) << 5)); }
DEVI void g8_stage_rc(int b, int& R, int& C) { const int st = b / 1024, sb = b % 1024, swz = sb ^ (((sb >> 9) & 1) << 5); R = (st >> 1) * 16 + swz / 64; C = (st & 1) * 32 + (swz % 64) / 2; }
#define G8_SA(b, h) (shm + ((b) * 2 + (h)) * 16384)
#define G8_SB(b, h) (shm + (4 + (b) * 2 + (h)) * 16384)
#define G8_STAGE(Pp, BASE, br, kt) do { const char* _g = (const char*)((BASE) + (long)(br) * K + (long)(kt) * 64); \
    __builtin_amdgcn_global_load_lds((const unsigned*)(_g + so0), (ldsu_t*)((Pp) + wdst), 16, 0, 0); \
    __builtin_amdgcn_global_load_lds((const unsigned*)(_g + (size_t)128 * K + so0), (ldsu_t*)((Pp) + wdst + 8192), 16, 0, 0); } while (0)
#define G8_LDA(b, h) _Pragma("unroll") for (int m = 0; m < 4; ++m) _Pragma("unroll") for (int k = 0; k < 2; ++k) At[m][k] = *(const __attribute__((address_space(3))) bf16x8*)(G8_SA(b, h) + aoff + m * 2048 + k * 1024)
#define G8_LDB(dst, b, h) _Pragma("unroll") for (int n = 0; n < 2; ++n) _Pragma("unroll") for (int k = 0; k < 2; ++k) dst[n][k] = *(const __attribute__((address_space(3))) bf16x8*)(G8_SB(b, h) + boff + n * 2048 + k * 1024)
#define G8_MMA(ai, bj, Bx) do { __builtin_amdgcn_s_setprio(1); \
    _Pragma("unroll") for (int m = 0; m < 4; ++m) _Pragma("unroll") for (int n = 0; n < 2; ++n) _Pragma("unroll") for (int k = 0; k < 2; ++k) \
        acc[ai][bj][m][n] = __builtin_amdgcn_mfma_f32_16x16x32_bf16(Bx[n][k], At[m][k], acc[ai][bj][m][n], 0, 0, 0); \
    __builtin_amdgcn_s_setprio(0); } while (0)
#define G8_WV(n) asm volatile("s_waitcnt vmcnt(" #n ")" ::: "memory")
#define G8_WL(n) asm volatile("s_waitcnt lgkmcnt(" #n ")" ::: "memory")
#define G8_BAR __builtin_amdgcn_s_barrier()
#define G8_SCHED __builtin_amdgcn_sched_barrier(0)

template <class Epi>
DEVI void gemm_phase8(const bf16_t* __restrict__ A, const bf16_t* __restrict__ Bt, const int K, const int nM, const int nN, const Epi& epi, unsigned char* lds, const int nsplit = 0) {
    ldsb_t* shm = (ldsb_t*)lds;
    const int t = tidx(), lane = t & 63, wid = t >> 6, wr = wid >> 2, wc = wid & 3, fr = lane & 15, fq = lane >> 4;
    unsigned so0;
    { int r, c; g8_stage_rc(t * 16, r, c); so0 = (unsigned)(r * K + c) * 2u; }
    const int wdst = __builtin_amdgcn_readfirstlane(wid * 1024);
    const int loff = g8_lds_byte(fr, fq * 8);
    const int aoff = loff + wr * 8192, boff = loff + wc * 4096;
    const int nwg = nM * nN, G = gridDim.x, ntk = K / 64;
    const int nunits = nwg + 2 * nN * nsplit;
    auto decode = [&](long L, int& pm, int& pn, int& kbeg, int& nt, int& part) {
        kbeg = 0; nt = ntk; part = -1;
        if (L < nwg) {
            int wgid = (int)L; { const int q = nwg / 8, r = nwg % 8, xcd = wgid % 8, off = wgid / 8; wgid = (xcd < r ? xcd * (q + 1) : r * (q + 1) + (xcd - r) * q) + off; }
            const int nig = 8 * nN, gid = wgid / nig, fm = gid * 8, gsz = (nM - fm) < 8 ? (nM - fm) : 8;
            pm = fm + ((wgid % nig) % gsz); pn = (wgid % nig) / gsz;
        } else {
            const int v = (int)L - nwg, sp = v % nsplit, tl = v / nsplit;
            pm = 64 + tl / nN; pn = tl % nN; part = sp;
            const int base = (ntk / nsplit) & ~1, extra = (ntk - base * nsplit) / 2;
            nt = base + (sp < extra ? 2 : 0); kbeg = sp * base + 2 * (sp < extra ? sp : extra);
        }
    };
    int pm = 0, pn = 0, kbeg = 0, nt = ntk, part = -1;
    if ((long)blockIdx.x >= nunits) return;
    decode(blockIdx.x, pm, pn, kbeg, nt, part);
    const bf16_t* Au = A + (size_t)pm * 256 * K + (size_t)kbeg * 64; const bf16_t* Bu = Bt + (size_t)pn * 256 * K + (size_t)kbeg * 64;
    f32x4 acc[2][2][4][2];
#pragma unroll
    for (int ai = 0; ai < 2; ++ai)
#pragma unroll
        for (int bj = 0; bj < 2; ++bj)
#pragma unroll
            for (int m = 0; m < 4; ++m)
#pragma unroll
                for (int n = 0; n < 2; ++n) acc[ai][bj][m][n] = (f32x4){0.f, 0.f, 0.f, 0.f};
    bf16x8 At[4][2], B0[2][2], B1[2][2];
    G8_WV(0);
    G8_STAGE(G8_SB(0, 0), Bu, 0, 0); G8_STAGE(G8_SB(0, 1), Bu, 128, 0); G8_STAGE(G8_SA(0, 0), Au, 0, 0); G8_STAGE(G8_SA(0, 1), Au, 128, 0);
    if (wr == 1) G8_BAR;
    G8_WV(2); G8_BAR;
    G8_STAGE(G8_SB(1, 0), Bu, 0, 1); G8_STAGE(G8_SA(1, 0), Au, 0, 1); G8_STAGE(G8_SB(1, 1), Bu, 128, 1);
    G8_WV(6); G8_BAR;
    for (int it = 0;; ++it) {
        int npm = pm, npn = pn, nkbeg = kbeg, nnt = nt, npart = part;
        const long Ln = (long)(it + 1) * G + blockIdx.x; const bool has_next = Ln < nunits;
        if (has_next) decode(Ln, npm, npn, nkbeg, nnt, npart);
        const bf16_t* nAu = has_next ? A + (size_t)npm * 256 * K + (size_t)nkbeg * 64 : Au; const bf16_t* nBu = has_next ? Bt + (size_t)npn * 256 * K + (size_t)nkbeg * 64 : Bu;
        for (int kt = 0; kt < nt; kt += 2) {
            const bool lastk = (kt == nt - 2);
            const bf16_t* A2 = lastk ? nAu : Au; const bf16_t* B2 = lastk ? nBu : Bu; const int k2 = lastk ? 0 : kt + 2;
            G8_LDB(B0, 0, 0); G8_LDB(B1, 0, 1); G8_SCHED; G8_LDA(0, 0); G8_STAGE(G8_SA(1, 1), Au, 128, kt + 1);
            G8_WV(8); G8_WL(0); G8_BAR; G8_MMA(0, 0, B0); G8_MMA(0, 1, B1); G8_BAR; G8_SCHED;
            G8_LDA(0, 1); G8_STAGE(G8_SB(0, 0), B2, 0, k2); G8_STAGE(G8_SB(0, 1), B2, 128, k2); G8_STAGE(G8_SA(0, 0), A2, 0, k2);
            G8_WV(8); G8_WL(0); G8_BAR; G8_MMA(1, 0, B0); G8_MMA(1, 1, B1); G8_BAR; G8_SCHED;
            G8_LDB(B0, 1, 0); G8_LDB(B1, 1, 1); G8_SCHED; G8_LDA(1, 0); G8_STAGE(G8_SA(0, 1), A2, 128, k2);
            G8_WV(8); G8_WL(0); G8_BAR; G8_MMA(0, 0, B0); G8_MMA(0, 1, B1); G8_BAR; G8_SCHED;
            G8_LDA(1, 1); G8_STAGE(G8_SB(1, 0), B2, 0, k2 + 1); G8_STAGE(G8_SB(1, 1), B2, 128, k2 + 1); G8_STAGE(G8_SA(1, 0), A2, 0, k2 + 1);
            G8_WV(8); G8_WL(0); G8_BAR; G8_MMA(1, 0, B0); G8_MMA(1, 1, B1); G8_BAR; G8_SCHED;
        }
        if (wr == 0) G8_BAR;
        epi(acc, pm, pn, wr, wc, fr, fq, part);
        if (!has_next) break;
#pragma unroll
        for (int ai = 0; ai < 2; ++ai)
#pragma unroll
            for (int bj = 0; bj < 2; ++bj)
#pragma unroll
                for (int m = 0; m < 4; ++m)
#pragma unroll
                    for (int n = 0; n < 2; ++n) acc[ai][bj][m][n] = (f32x4){0.f, 0.f, 0.f, 0.f};
        pm = npm; pn = npn; kbeg = nkbeg; nt = nnt; part = npart; Au = nAu; Bu = nBu;
        if (wr == 1) G8_BAR;
    }
    G8_WV(0);
    G8_BAR;
}


struct EpiInProj {
    bf16_t* P; bf16_t* VTL; bf16_t* VTC;
    DEVI void operator()(const f32x4 (&acc)[2][2][4][2], int pm, int pn, int wr, int wc, int fr, int fq, int part = -1) const {
#pragma unroll
        for (int ai = 0; ai < 2; ++ai)
#pragma unroll
            for (int m = 0; m < 4; ++m) {
                const int r = pm * 256 + ai * 128 + wr * 64 + m * 16 + fr;
#pragma unroll
                for (int bj = 0; bj < 2; ++bj) {
                    const int c = pn * 256 + bj * 128 + wc * 32 + fq * 8;
                    const f32x4 v0 = acc[ai][bj][m][0], v1 = acc[ai][bj][m][1];
                    if (pn == 2 && bj == 1) {
                        const int di = c - 640, kvh = di >> 6, d = di & 63;
                        bf16_t* dst; int stride;
                        if (r < TOKL) { const int b = r >> 13, tt = r & 8191; dst = VTL + ((size_t)((b * 2 + kvh) * 64 + d)) * SEQ + tt; stride = SEQ; }
                        else { const int rc = r - TOKL, b = rc >> 8, tt = rc & 255; dst = VTC + ((size_t)((b * 2 + kvh) * 64 + d)) * CTXL + tt; stride = CTXL; }
                        dst[0] = f2bf(v0.x); dst[stride] = f2bf(v0.y); dst[2 * stride] = f2bf(v0.z); dst[3 * stride] = f2bf(v0.w);
                        dst[4 * stride] = f2bf(v1.x); dst[5 * stride] = f2bf(v1.y); dst[6 * stride] = f2bf(v1.z); dst[7 * stride] = f2bf(v1.w);
                    } else {
                        u32x4 o; o.x = pk2(v0.x, v0.y); o.y = pk2(v0.z, v0.w); o.z = pk2(v1.x, v1.y); o.w = pk2(v1.z, v1.w);
                        *(u32x4*)(P + (size_t)r * INWP + c) = o;
                    }
                }
            }
    }
};
struct EpiResid {
    const float* baseL; const float* baseC; float* outL; float* outC; const float* mod; int goff; float* partbuf;
    DEVI void operator()(const f32x4 (&acc)[2][2][4][2], int pm, int pn, int wr, int wc, int fr, int fq, int part = -1) const {
        const int vec = pm < 32 ? 0 : (pm < 64 ? 1 : 2);
        const int r0 = pm * 256 + wr * 64 + fr, c0 = pn * 256 + wc * 32 + fq * 8;
        const float* gt = mod + vec * 6144 + goff + c0;
        f32x4 gv[2][2];
#pragma unroll
        for (int bj = 0; bj < 2; ++bj)
#pragma unroll
            for (int n = 0; n < 2; ++n) gv[bj][n] = *(const f32x4*)(gt + bj * 128 + n * 4);
        if (part >= 0) {
#pragma unroll
            for (int ai = 0; ai < 2; ++ai)
#pragma unroll
                for (int m = 0; m < 4; ++m)
#pragma unroll
                    for (int bj = 0; bj < 2; ++bj)
#pragma unroll
                        for (int n = 0; n < 2; ++n)
                            *(f32x4*)(partbuf + ((size_t)part * TOKC + (r0 + ai * 128 + m * 16 - TOKL)) * DM + c0 + bj * 128 + n * 4) = gv[bj][n] * acc[ai][bj][m][n];
            return;
        }
        const float* base = pm < 64 ? baseL + (size_t)r0 * DM + c0 : baseC + (size_t)(r0 - TOKL) * DM + c0;
        float* dst = pm < 64 ? outL + (size_t)r0 * DM + c0 : outC + (size_t)(r0 - TOKL) * DM + c0;
#pragma unroll
        for (int ai = 0; ai < 2; ++ai) {
            f32x4 bv[4][2][2];
#pragma unroll
            for (int m = 0; m < 4; ++m)
#pragma unroll
                for (int bj = 0; bj < 2; ++bj)
#pragma unroll
                    for (int n = 0; n < 2; ++n) bv[m][bj][n] = *(const f32x4*)(base + (size_t)(ai * 128 + m * 16) * DM + bj * 128 + n * 4);
#pragma unroll
            for (int m = 0; m < 4; ++m)
#pragma unroll
                for (int bj = 0; bj < 2; ++bj)
#pragma unroll
                    for (int n = 0; n < 2; ++n) *(f32x4*)(dst + (size_t)(ai * 128 + m * 16) * DM + bj * 128 + n * 4) = bv[m][bj][n] + gv[bj][n] * acc[ai][bj][m][n];
        }
    }
};
struct EpiSwiglu {
    bf16_t* HID;
    DEVI void operator()(const f32x4 (&acc)[2][2][4][2], int pm, int pn, int wr, int wc, int fr, int fq, int part = -1) const {
#pragma unroll
        for (int ai = 0; ai < 2; ++ai)
#pragma unroll
            for (int m = 0; m < 4; ++m) {
                const int r = pm * 256 + ai * 128 + wr * 64 + m * 16 + fr;
                const int c = pn * 128 + wc * 32 + fq * 8;
                const f32x4 g0 = acc[ai][0][m][0], u0 = acc[ai][1][m][0], g1 = acc[ai][0][m][1], u1 = acc[ai][1][m][1];
                u32x4 o; o.x = pk2(silu_f(g0.x) * u0.x, silu_f(g0.y) * u0.y); o.y = pk2(silu_f(g0.z) * u0.z, silu_f(g0.w) * u0.w);
                o.z = pk2(silu_f(g1.x) * u1.x, silu_f(g1.y) * u1.y); o.w = pk2(silu_f(g1.z) * u1.z, silu_f(g1.w) * u1.w);
                *(u32x4*)(HID + (size_t)r * FFH + c) = o;
            }
    }
};

constexpr int ROPE_LDS_OFF = 114688;
DEVI void stage_norm_rope(const u32x4 raw, int row, int seg, const float* __restrict__ gn, bool rope, int pos, const float* ropel, float scale, bf16_t* dst) {
    float v[8]; unpack8(raw, v);
    float ss = 0.f;
#pragma unroll
    for (int j = 0; j < 8; ++j) ss += v[j] * v[j];
    ss += dpp_xor1(ss); ss += dpp_xor2(ss); ss += __shfl_xor(ss, 4);
    const float rstd = rsqrtf(ss * (1.f / 64.f) + 1e-6f);
    const f32x4 g0 = *(const f32x4*)(gn + seg * 8), g1 = *(const f32x4*)(gn + seg * 8 + 4);
    const float gg[8] = {g0.x, g0.y, g0.z, g0.w, g1.x, g1.y, g1.z, g1.w};
#pragma unroll
    for (int j = 0; j < 8; ++j) v[j] = v[j] * rstd * gg[j];
    float o[8];
    if (rope) {
        const int ap = (seg < 4) ? (pos >> 6) : (pos & 63);
        const float* tb = ropel + ap * 16 + (seg & 1) * 8;
        const f32x4 c0 = *(const f32x4*)tb, c1 = *(const f32x4*)(tb + 4), s0 = *(const f32x4*)(tb + 2048), s1 = *(const f32x4*)(tb + 2052);
        const float cs[8] = {c0.x, c0.y, c0.z, c0.w, c1.x, c1.y, c1.z, c1.w}, sn[8] = {s0.x, s0.y, s0.z, s0.w, s1.x, s1.y, s1.z, s1.w};
#pragma unroll
        for (int j = 0; j < 8; ++j) { const float pv = dpp_xor2(v[j]); o[j] = ((seg & 2) ? (v[j] * cs[j] + pv * sn[j]) : (v[j] * cs[j] - pv * sn[j])) * scale; }
    } else {
#pragma unroll
        for (int j = 0; j < 8; ++j) o[j] = v[j] * scale;
    }
    *(u32x4*)(dst + row * 72 + seg * 8) = pack8(o);
}

DEVI void attn_item(const Params& p, int l, int item, unsigned char* lds) {
    const int t = tidx(), lane = t & 63, wid = t >> 6, fr = lane & 15, fq = lane >> 4;
    const bf16_t* P = (const bf16_t*)(p.ws + WS_P);
    const bf16_t* VTL = (const bf16_t*)(p.ws + WS_VTL);
    const bf16_t* VTC = (const bf16_t*)(p.ws + WS_VTC);
    bf16_t* MIX = (bf16_t*)(p.ws + WS_MIX);
    const float* ropel = (const float*)(lds + ROPE_LDS_OFF);
    const float* qg = p.qg + l * 64; const float* kgn = p.kg + l * 64;
    bf16_t* Qs = (bf16_t*)lds;
    bf16_t* Ks = Qs + 512 * 72;
    bf16_t* Vs = Ks + 64 * 72;
    int b, qb, kvh; bool isctx; int qrow0;
    if (item < 256) { isctx = false; b = item >> 7; qb = (item >> 1) & 63; kvh = item & 1; qrow0 = b * SEQ + qb * 128; }
    else { const int ci = item - 256; isctx = true; b = ci >> 2; qb = (ci >> 1) & 1; kvh = ci & 1; qrow0 = TOKL + b * CTXL + qb * 128; }
    const int lo = isctx ? 0 : (qb * 2 - 2 < 0 ? 0 : qb * 2 - 2), hi = isctx ? -1 : (qb * 2 + 3 > 127 ? 127 : qb * 2 + 3);
    const int nl = hi - lo + 1, ntile = nl + 4;
    const int key = t >> 3, seg = t & 7;
    const size_t vrow = (size_t)((b * 2 + kvh) * 64 + key);
    u32x4 kraw, vraw;
    {
        const bool loc0 = nl > 0; const int kt0 = loc0 ? lo : 0;
        const size_t krow = loc0 ? ((size_t)b * SEQ + kt0 * 64 + key) : ((size_t)TOKL + b * CTXL + kt0 * 64 + key);
        kraw = *(const u32x4*)(P + krow * INWP + 512 + kvh * 64 + seg * 8);
        vraw = *(const u32x4*)(loc0 ? (VTL + vrow * SEQ + kt0 * 64 + seg * 8) : (VTC + vrow * CTXL + kt0 * 64 + seg * 8));
    }
    __syncthreads();
    {
        u32x4 qraw[8];
#pragma unroll
        for (int i = 0; i < 8; ++i) { const int id = i * NT + t, row = id >> 3, g = row >> 7, rr = row & 127; qraw[i] = *(const u32x4*)(P + (size_t)(qrow0 + rr) * INWP + (kvh * 4 + g) * 64 + (id & 7) * 8); }
#pragma unroll
        for (int i = 0; i < 8; ++i) { const int id = i * NT + t, row = id >> 3, rr = row & 127; stage_norm_rope(qraw[i], row, id & 7, qg, !isctx, qb * 128 + rr, ropel, 0.125f * 1.44269504f, Qs); }
    }
    {
        const bool loc0 = nl > 0; const int kt0 = loc0 ? lo : 0;
        stage_norm_rope(kraw, key, seg, kgn, loc0, kt0 * 64 + key, ropel, 1.f, Ks);
        *(u32x4*)(Vs + key * 72 + seg * 8) = vraw;
    }
    __syncthreads();
    const int g = wid >> 1, half = wid & 1;
    const bf16_t* Qw = Qs + (g * 128 + half * 64 + fr) * 72 + fq * 8;
    const float sinkv = p.sink[l * 8 + kvh * 4 + g] * 1.44269504f;
    float mrun[4], lrun[4]; f32x4 o[4][4];
#pragma unroll
    for (int n = 0; n < 4; ++n) { mrun[n] = sinkv; lrun[n] = fq == 0 ? 1.f : 0.f;
#pragma unroll
        for (int dt = 0; dt < 4; ++dt) o[dt][n] = (f32x4){0.f, 0.f, 0.f, 0.f}; }
    for (int ti = 0; ti < ntile; ++ti) {
        const bool local = ti < nl; const int kt = local ? lo + ti : ti - nl;
        const bool more = ti + 1 < ntile;
        const bool nloc = (ti + 1) < nl; const int nkt = nloc ? lo + ti + 1 : ti + 1 - nl;
        if (more) {
            const size_t krow = nloc ? ((size_t)b * SEQ + nkt * 64 + key) : ((size_t)TOKL + b * CTXL + nkt * 64 + key);
            kraw = *(const u32x4*)(P + krow * INWP + 512 + kvh * 64 + seg * 8);
            vraw = *(const u32x4*)(nloc ? (VTL + vrow * SEQ + nkt * 64 + seg * 8) : (VTC + vrow * CTXL + nkt * 64 + seg * 8));
        }
        const bool domask = local && (kt < 2 * qb || kt > 2 * qb + 1);
#pragma unroll 1
        for (int kh = 0; kh < 2; ++kh) {
            f32x4 s[2][4];
#pragma unroll
            for (int m = 0; m < 2; ++m)
#pragma unroll
                for (int n = 0; n < 4; ++n) s[m][n] = (f32x4){0.f, 0.f, 0.f, 0.f};
#pragma unroll
            for (int ks = 0; ks < 2; ++ks) {
                bf16x8 qf[4];
#pragma unroll
                for (int n = 0; n < 4; ++n) qf[n] = *(const bf16x8*)(Qw + n * 16 * 72 + ks * 32);
#pragma unroll
                for (int m = 0; m < 2; ++m) {
                    const bf16x8 kf = *(const bf16x8*)(Ks + ((kh * 2 + m) * 16 + fr) * 72 + ks * 32 + fq * 8);
#pragma unroll
                    for (int n = 0; n < 4; ++n) s[m][n] = mfma16(kf, qf[n], s[m][n]);
                }
            }
            if (domask) {
#pragma unroll
                for (int m = 0; m < 2; ++m)
#pragma unroll
                    for (int n = 0; n < 4; ++n)
#pragma unroll
                        for (int j = 0; j < 4; ++j) {
                            const int kpos = kt * 64 + (kh * 2 + m) * 16 + fq * 4 + j, qpos = qb * 128 + half * 64 + n * 16 + fr;
                            const int df = qpos - kpos;
                            if (df > 128 || df < -128) s[m][n][j] = -1e30f;
                        }
            }
#pragma unroll
            for (int n = 0; n < 4; ++n) {
                float mx = -1e30f;
#pragma unroll
                for (int m = 0; m < 2; ++m)
#pragma unroll
                    for (int j = 0; j < 4; ++j) mx = fmaxf(mx, s[m][n][j]);
                if (__builtin_amdgcn_ballot_w64(mx > mrun[n] + 8.f) != 0ull) {
                    mx = red_max_16_32(mx);
                    const float mnew = fmaxf(mrun[n], mx);
                    const float alpha = __builtin_amdgcn_exp2f(mrun[n] - mnew);
                    lrun[n] *= alpha; mrun[n] = mnew;
#pragma unroll
                    for (int dt = 0; dt < 4; ++dt) o[dt][n] = o[dt][n] * alpha;
                }
                const float mref = mrun[n];
                float rs = 0.f;
#pragma unroll
                for (int m = 0; m < 2; ++m)
#pragma unroll
                    for (int j = 0; j < 4; ++j) { const float pv = __builtin_amdgcn_exp2f(s[m][n][j] - mref); s[m][n][j] = pv; rs += pv; }
                lrun[n] += rs;
            }
            {
                bf16x8 pb[4];
#pragma unroll
                for (int n = 0; n < 4; ++n) {
                    u32x4 u; u.x = pk2(s[0][n][0], s[0][n][1]); u.y = pk2(s[0][n][2], s[0][n][3]); u.z = pk2(s[1][n][0], s[1][n][1]); u.w = pk2(s[1][n][2], s[1][n][3]);
                    pb[n] = __builtin_bit_cast(bf16x8, u);
                }
#pragma unroll
                for (int dt = 0; dt < 4; ++dt) {
                    const bf16x4 v0 = *(const bf16x4*)(Vs + (dt * 16 + fr) * 72 + (2 * kh) * 16 + fq * 4);
                    const bf16x4 v1 = *(const bf16x4*)(Vs + (dt * 16 + fr) * 72 + (2 * kh + 1) * 16 + fq * 4);
                    const bf16x8 va = __builtin_shufflevector(v0, v1, 0, 1, 2, 3, 4, 5, 6, 7);
#pragma unroll
                    for (int n = 0; n < 4; ++n) o[dt][n] = mfma16(va, pb[n], o[dt][n]);
                }
            }
        }
        if (more) {
            __syncthreads();
            stage_norm_rope(kraw, key, seg, kgn, nloc, nkt * 64 + key, ropel, 1.f, Ks);
            *(u32x4*)(Vs + key * 72 + seg * 8) = vraw;
            __syncthreads();
        }
    }
#pragma unroll
    for (int n = 0; n < 4; ++n) {
        const float inv = 1.f / red_sum_16_32(lrun[n]);
        const size_t row = (size_t)qrow0 + half * 64 + n * 16 + fr;
#pragma unroll
        for (int dt = 0; dt < 4; ++dt) {
            const f32x4 v = o[dt][n] * inv;
            u32x2 u; u.x = pk2(v.x, v.y); u.y = pk2(v.z, v.w);
            *(u32x2*)(MIX + row * DM + (kvh * 4 + g) * 64 + dt * 16 + fq * 4) = u;
        }
    }
}

DEVI void f1_load(const Params& p, int item, u32x4& a, u32x4& c2) {
    const int t = tidx(), g = item & 3, n2 = (item >> 2) & 63, b = item >> 8, n1 = t >> 2, cs = (t & 3) * 16;
    const bf16_t* src = (const bf16_t*)(p.ws + WS_P) + (size_t)(b * SEQ + 64 * n1 + n2) * INWP + 768 + g * 64 + cs;
    a = *(const u32x4*)src; c2 = *(const u32x4*)(src + 8);
}
DEVI void f1_item(const Params& p, int item, unsigned char* lds, u32x4& a, u32x4& c2, int next) {
    const int t = tidx(), lane = t & 63, w = t >> 6, fr = lane & 15, fq = lane >> 4;
    const int g = item & 3, n2 = (item >> 2) & 63, b = item >> 8;
    const bf16_t* D128 = (const bf16_t*)(p.ws + WS_D128);
    bf16_t* YP = (bf16_t*)(p.ws + WS_YP);
    bf16_t* uT = (bf16_t*)lds;
    __syncthreads();
    {
        const int n1 = t >> 2, cs = (t & 3) * 16;
        const unsigned uu[8] = {a.x, a.y, a.z, a.w, c2.x, c2.y, c2.z, c2.w};
        if (next >= 0) f1_load(p, next, a, c2);
#pragma unroll
        for (int i = 0; i < 8; ++i) { uT[(cs + 2 * i) * 136 + n1] = (bf16_t)(uu[i] & 0xffffu); uT[(cs + 2 * i + 1) * 136 + n1] = (bf16_t)(uu[i] >> 16); }
    }
    __syncthreads();
    f32x4 ar[4], ai[4];
#pragma unroll
    for (int n = 0; n < 4; ++n) { ar[n] = (f32x4){0.f, 0.f, 0.f, 0.f}; ai[n] = (f32x4){0.f, 0.f, 0.f, 0.f}; }
#pragma unroll
    for (int ks = 0; ks < 4; ++ks) {
        const bf16x8 a0 = *(const bf16x8*)(D128 + ((2 * w) * 16 + fr) * 128 + ks * 32 + fq * 8);
        const bf16x8 a1 = *(const bf16x8*)(D128 + ((2 * w + 1) * 16 + fr) * 128 + ks * 32 + fq * 8);
#pragma unroll
        for (int n = 0; n < 4; ++n) {
            const bf16x8 bb = *(const bf16x8*)(uT + (n * 16 + fr) * 136 + ks * 32 + fq * 8);
            ar[n] = mfma16(a0, bb, ar[n]); ai[n] = mfma16(a1, bb, ai[n]);
        }
    }
#pragma unroll
    for (int j = 0; j < 4; ++j) {
        const int k1 = 16 * w + fq * 4 + j;
        const float a = (float)(n2 * k1) * (1.f / 8192.f);
        const float tc = __builtin_amdgcn_cosf(a), ts = __builtin_amdgcn_sinf(a);
#pragma unroll
        for (int n = 0; n < 4; ++n) {
            const int c = n * 16 + fr;
            const float yr = ar[n][j], yi = ai[n][j];
            const float pr = yr * tc + yi * ts, pi = yi * tc - yr * ts;
            const size_t base = ((size_t)((b * 4 + g) * 128 + k1) * 2) * 4096 + n2 * 64 + c;
            YP[base] = f2bf(pr); YP[base + 4096] = f2bf(pi);
        }
    }
}

DEVI void f2_load(const Params& p, int item, bool cx, u32x4& a, u32x4& c2) {
    const int t = tidx(), rowi = t >> 2, cs = (t & 3) * 16;
    const int k1 = cx ? (item & 3) : (item & 127), g = cx ? ((item >> 2) & 3) : ((item >> 7) & 3), b = cx ? (item >> 4) : (item >> 9);
    const bf16_t* src = (const bf16_t*)(p.ws + (cx ? WS_YPC : WS_YP)) + ((size_t)((b * 4 + g) * (cx ? 4 : 128) + k1) * 128 + rowi) * 64 + cs;
    a = *(const u32x4*)src; c2 = *(const u32x4*)(src + 8);
}
DEVI void f2_item(const Params& p, int l, int item, unsigned char* lds, const bool cx, u32x4& a, u32x4& c2, int next, bool nextcx) {
    const int t = tidx(), lane = t & 63, w = t >> 6, fr = lane & 15, fq = lane >> 4;
    const int k1 = cx ? (item & 3) : (item & 127), g = cx ? ((item >> 2) & 3) : ((item >> 7) & 3), b = cx ? (item >> 4) : (item >> 9);
    const bf16_t* T64 = (const bf16_t*)(p.ws + WS_T64);
    const bf16_t* MMT = (const bf16_t*)(p.ws + WS_MMT) + (size_t)(l * 4 + g) * 8192;
    bf16_t* MIX = (bf16_t*)(p.ws + WS_MIX);
    bf16_t* Bt = (bf16_t*)lds;
    bf16_t* XX = Bt + 64 * 136;
    __syncthreads();
    {
        const int rowi = t >> 2, cs = (t & 3) * 16;
        const unsigned uu[8] = {a.x, a.y, a.z, a.w, c2.x, c2.y, c2.z, c2.w};
        if (next >= 0) f2_load(p, next, nextcx, a, c2);
#pragma unroll
        for (int i = 0; i < 8; ++i) { Bt[(cs + 2 * i) * 136 + rowi] = (bf16_t)(uu[i] & 0xffffu); Bt[(cs + 2 * i + 1) * 136 + rowi] = (bf16_t)(uu[i] >> 16); }
    }
    __syncthreads();
    f32x4 acc[4];
#pragma unroll
    for (int n = 0; n < 4; ++n) acc[n] = (f32x4){0.f, 0.f, 0.f, 0.f};
#pragma unroll
    for (int ks = 0; ks < 4; ++ks) {
        const bf16x8 a = *(const bf16x8*)(T64 + (w * 16 + fr) * 128 + ks * 32 + fq * 8);
#pragma unroll
        for (int n = 0; n < 4; ++n) acc[n] = mfma16(a, *(const bf16x8*)(Bt + (n * 16 + fr) * 136 + ks * 32 + fq * 8), acc[n]);
    }
    {
        const int po = w & 1;
#pragma unroll
        for (int n = 0; n < 4; ++n)
#pragma unroll
            for (int j = 0; j < 4; ++j) { const int k2 = (w >> 1) * 16 + fq * 4 + j; XX[k2 * 136 + po * 64 + n * 16 + fr] = f2bf(acc[n][j]); }
    }
    __syncthreads();
    const int kt2 = w >> 1;
    f32x4 a2[2];
    a2[0] = (f32x4){0.f, 0.f, 0.f, 0.f}; a2[1] = (f32x4){0.f, 0.f, 0.f, 0.f};
#pragma unroll
    for (int ks = 0; ks < 4; ++ks) {
        const bf16x8 bx = *(const bf16x8*)(XX + (kt2 * 16 + fr) * 136 + ks * 32 + fq * 8);
#pragma unroll
        for (int ei = 0; ei < 2; ++ei) { const int et = (w & 1) * 2 + ei; a2[ei] = mfma16(*(const bf16x8*)(MMT + (et * 16 + fr) * 128 + ks * 32 + fq * 8), bx, a2[ei]); }
    }
#pragma unroll
    for (int ei = 0; ei < 2; ++ei) {
        const int et = (w & 1) * 2 + ei, k2 = kt2 * 16 + fr, e = et * 16 + fq * 4;
        const float sc = cx ? 5.656854249f : 1.f;
        u32x2 u; u.x = pk2(a2[ei].x * sc, a2[ei].y * sc); u.y = pk2(a2[ei].z * sc, a2[ei].w * sc);
        const size_t orow = cx ? (size_t)(TOKL + b * CTXL + k1 + 4 * k2) : (size_t)(b * SEQ + k1 + 128 * k2);
        *(u32x2*)(MIX + orow * DM + 512 + g * 64 + e) = u;
    }
}

DEVI void cf_item(const Params& p, int l, int item, unsigned char* lds) {
    const int t = tidx();
    const int g = item & 3, b = item >> 2;
    const bf16_t* P = (const bf16_t*)(p.ws + WS_P);
    bf16_t* YPC = (bf16_t*)(p.ws + WS_YPC);
    const int n2 = t >> 3, cg8 = (t & 7) * 8;
    float u[4][8];
#pragma unroll
    for (int n1 = 0; n1 < 4; ++n1) unpack8(*(const u32x4*)(P + (size_t)(TOKL + b * CTXL + 64 * n1 + n2) * INWP + 768 + g * 64 + cg8), u[n1]);
#pragma unroll
    for (int k1 = 0; k1 < 4; ++k1) {
        const float a = (float)(n2 * k1) * (1.f / 256.f); const float tc = __builtin_amdgcn_cosf(a), ts = __builtin_amdgcn_sinf(a);
        float pr[8], pi[8];
#pragma unroll
        for (int i = 0; i < 8; ++i) {
            float yr, yi;
            if (k1 == 0) { yr = (u[0][i] + u[2][i]) + (u[1][i] + u[3][i]); yi = 0.f; }
            else if (k1 == 1) { yr = u[0][i] - u[2][i]; yi = u[3][i] - u[1][i]; }
            else if (k1 == 2) { yr = (u[0][i] + u[2][i]) - (u[1][i] + u[3][i]); yi = 0.f; }
            else { yr = u[0][i] - u[2][i]; yi = u[1][i] - u[3][i]; }
            pr[i] = yr * tc + yi * ts; pi[i] = yi * tc - yr * ts;
        }
        bf16_t* dst = YPC + ((size_t)(((b * 4 + g) * 4 + k1) * 2)) * 4096 + n2 * 64 + cg8;
        *(u32x4*)dst = pack8(pr); *(u32x4*)(dst + 4096) = pack8(pi);
    }
}

DEVI void gla_gates16(const Params& p, int l, int row0, int h, float* gzs, float (&v)[16]) {
    const int t = tidx();
    const bf16_t* P = (const bf16_t*)(p.ws + WS_P);
    float w[16]; float bias;
    {
        const int d = t & 63, dir = (t >> 6) & 1;
        const float* wg = (dir ? p.wgb : p.wgf) + (size_t)l * 16 * 256 + h * 64 + d;
        bias = (dir ? p.bgb : p.bgf)[l * 256 + h * 64 + d];
#pragma unroll
        for (int r = 0; r < 16; ++r) w[r] = wg[r * 256];
    }
    {
        const int tok = t >> 3, sg = (t & 7) * 4;
        const u32x2 u = *(const u32x2*)(P + (size_t)(row0 + tok) * INWP + 2048 + sg);
        gzs[tok * 32 + sg + 0] = bflo(u.x); gzs[tok * 32 + sg + 1] = bfhi(u.x); gzs[tok * 32 + sg + 2] = bflo(u.y); gzs[tok * 32 + sg + 3] = bfhi(u.y);
    }
    __syncthreads();
    {
        const int dir = (t >> 6) & 1, tq = t >> 7;
#pragma unroll
        for (int i = 0; i < 16; ++i) {
            const int tok = tq * 16 + i;
            float z = bias;
#pragma unroll
            for (int r = 0; r < 16; ++r) z += gzs[tok * 32 + dir * 16 + r] * w[r];
            const float ls = fminf(z, 0.f) - __logf(1.f + __expf(-fabsf(z)));
            v[i] = ls * (1.f / 16.f);
        }
    }
    __syncthreads();
}
DEVI void gla_scan16(float (&v)[16], float* la, float* gzs) {
    const int t = tidx();
    const int d = t & 63, dir = (t >> 6) & 1, q = t >> 7;
    float* col = la + (dir * 64) * 64 + d;
    if (dir == 0) {
#pragma unroll
        for (int i = 1; i < 16; ++i) v[i] += v[i - 1];
        gzs[(q * 2 + dir) * 64 + d] = v[15];
    } else {
#pragma unroll
        for (int i = 14; i >= 0; --i) v[i] += v[i + 1];
        gzs[(q * 2 + dir) * 64 + d] = v[0];
    }
    __syncthreads();
    float off = 0.f;
#pragma unroll
    for (int qq = 0; qq < 4; ++qq) { const float tv = gzs[(qq * 2 + dir) * 64 + d]; if (dir == 0 ? (qq < q) : (qq > q)) off += tv; }
#pragma unroll
    for (int i = 0; i < 16; ++i) col[(q * 16 + i) * 64] = v[i] + off;
    __syncthreads();
}
DEVI int gla_row0(int b, int mc) { return mc < 4 ? (TOKL + b * CTXL + mc * 64) : (b * SEQ + (mc - 4) * 64); }
DEVI int gla_ci(int dir, int mc) { return dir == 0 ? mc : (mc < 4 ? 3 - mc : 135 - mc); }

DEVI void g1_item(const Params& p, int l, int item, unsigned char* lds) {
    const int t = tidx(), lane = t & 63, w = t >> 6, fr = lane & 15, fq = lane >> 4;
    const int h = item & 3, mc = (item >> 2) % NCI, b = (item >> 2) / NCI;
    const int row0 = gla_row0(b, mc);
    const bf16_t* P = (const bf16_t*)(p.ws + WS_P);
    bf16_t* UT = (bf16_t*)(p.ws + WS_UT);
    float* DEC = (float*)(p.ws + WS_DEC);
    float* la = (float*)lds;
    bf16_t* kT = (bf16_t*)(lds + 32768);
    bf16_t* vT = kT + 2 * 64 * 72;
    float* gzs = (float*)(lds + 32768 + 3 * 64 * 72 * 2);
    const u32x4 kraw = *(const u32x4*)(P + (size_t)(row0 + (t >> 3)) * INWP + 1280 + h * 64 + (t & 7) * 8);
    const u32x4 vraw = *(const u32x4*)(P + (size_t)(row0 + (t >> 3)) * INWP + 1536 + h * 64 + (t & 7) * 8);
    __syncthreads();
    {
        float lv[16];
        gla_gates16(p, l, row0, h, gzs, lv);
        bf16_t* LA = (bf16_t*)(p.ws + WS_LA) + (size_t)item * 8192 + (((t >> 6) & 1) * 64 + (t >> 7) * 16) * 64 + (t & 63);
#pragma unroll
        for (int i2 = 0; i2 < 16; ++i2) LA[i2 * 64] = f2bf(lv[i2]);
        gla_scan16(lv, la, gzs);
    }
    {
        const int s = t >> 3, seg = (t & 7) * 8;
        float kv[8], vv[8];
        unpack8(kraw, kv);
        unpack8(vraw, vv);
#pragma unroll
        for (int i = 0; i < 8; ++i) {
            const int d = seg + i;
            const float bt0 = la[63 * 64 + d], bt1 = la[64 * 64 + d];
            kT[(d) * 72 + s] = f2bf(kv[i] * __expf(bt0 - la[s * 64 + d]));
            kT[(64 + d) * 72 + s] = f2bf(kv[i] * __expf(bt1 - la[(64 + s) * 64 + d]));
            vT[d * 72 + s] = raw16(vraw, i);
        }
        if (t < 128) { const int dir = t >> 6, d = t & 63; const float bt = dir ? la[64 * 64 + d] : la[63 * 64 + d];
            DEC[((size_t)((b * 2 + dir) * NCI + gla_ci(dir, mc)) * 4 + h) * 64 + d] = __expf(bt); }
    }
    __syncthreads();
    {
        const int dir = w >> 2, mt = w & 3;
        f32x4 acc[4];
#pragma unroll
        for (int n = 0; n < 4; ++n) acc[n] = (f32x4){0.f, 0.f, 0.f, 0.f};
#pragma unroll
        for (int ks = 0; ks < 2; ++ks) {
            const bf16x8 a = *(const bf16x8*)(kT + (dir * 64 + mt * 16 + fr) * 72 + ks * 32 + fq * 8);
#pragma unroll
            for (int n = 0; n < 4; ++n) acc[n] = mfma16(a, *(const bf16x8*)(vT + (n * 16 + fr) * 72 + ks * 32 + fq * 8), acc[n]);
        }
        bf16_t* dst = UT + ((size_t)((b * 2 + dir) * NCI + gla_ci(dir, mc)) * 4 + h) * 4096;
#pragma unroll
        for (int n = 0; n < 4; ++n) { u32x2 u; u.x = pk2(acc[n].x, acc[n].y); u.y = pk2(acc[n].z, acc[n].w); *(u32x2*)(dst + (n * 16 + fr) * 64 + mt * 16 + fq * 4) = u; }
    }
}

DEVI void g2_item(const Params& p, int item) {
    const int gid = item * NT + tidx();
    const int d = gid & 63, e = (gid >> 6) & 63, h = (gid >> 12) & 3, bd = gid >> 14;
    bf16_t* u = (bf16_t*)(p.ws + WS_UT) + ((size_t)bd * NCI * 4 + h) * 4096 + e * 64 + d;
    const float* dc = (const float*)(p.ws + WS_DEC) + ((size_t)bd * NCI * 4 + h) * 64 + d;
    float s = 0.f;
    for (int c0 = 0; c0 < NCI; c0 += 33) {
        float uv[33], dv[33];
#pragma unroll
        for (int i = 0; i < 33; ++i) { uv[i] = bf2f(u[(size_t)(c0 + i) * 4 * 4096]); dv[i] = dc[(size_t)(c0 + i) * 256]; }
#pragma unroll
        for (int i = 0; i < 33; ++i) { u[(size_t)(c0 + i) * 4 * 4096] = f2bf(s); s = dv[i] * s + uv[i]; }
    }
}

struct G3Pre { u32x4 q, k, v, r; bf16_t la[16]; };
DEVI void g3_load(const Params& p, int item, G3Pre& d) {
    const int t = tidx();
    const int h = item & 3, mc = (item >> 2) % NCI, b = (item >> 2) / NCI;
    const int row0 = mc < 4 ? (TOKL + b * CTXL + mc * 64) : (b * SEQ + (mc - 4) * 64);
    const bf16_t* prow = (const bf16_t*)(p.ws + WS_P) + (size_t)(row0 + (t >> 3)) * INWP + h * 64 + (t & 7) * 8;
    d.q = *(const u32x4*)(prow + 1024); d.k = *(const u32x4*)(prow + 1280); d.v = *(const u32x4*)(prow + 1536); d.r = *(const u32x4*)(prow + 1792);
    const bf16_t* LA = (const bf16_t*)(p.ws + WS_LA) + (size_t)item * 8192 + (((t >> 6) & 1) * 64 + (t >> 7) * 16) * 64 + (t & 63);
#pragma unroll
    for (int i2 = 0; i2 < 16; ++i2) d.la[i2] = LA[i2 * 64];
}
DEVI void g3_item(const Params& p, int l, int item, unsigned char* lds, G3Pre& pre, int next) {
    const int t = tidx(), lane = t & 63, w = t >> 6, fr = lane & 15, fq = lane >> 4;
    const int h = item & 3, mc = (item >> 2) % NCI, b = (item >> 2) / NCI;
    const int row0 = gla_row0(b, mc);
    const bf16_t* P = (const bf16_t*)(p.ws + WS_P);
    const bf16_t* ST = (const bf16_t*)(p.ws + WS_UT);
    bf16_t* MIX = (bf16_t*)(p.ws + WS_MIX);
    float* la = (float*)lds;
    bf16_t* qi = (bf16_t*)(lds + 32768);
    bf16_t* ki = (bf16_t*)(lds + 51200);
    bf16_t* vT = (bf16_t*)(lds + 69632);
    bf16_t* sT = (bf16_t*)(lds + 78848);
    float* gzs = (float*)(lds + 97280);
    float* O = (float*)(lds + 105472);
    const u32x4 qraw = pre.q, kraw = pre.k, vraw = pre.v, rraw = pre.r;
    float lv[16];
#pragma unroll
    for (int i2 = 0; i2 < 16; ++i2) lv[i2] = bf2f(pre.la[i2]);
    if (next >= 0) g3_load(p, next, pre);
    __syncthreads();
    gla_scan16(lv, la, gzs);
    {
        const int s = t >> 3, seg = (t & 7) * 8;
        float qv[8], kv[8], vv[8];
        unpack8(qraw, qv);
        unpack8(kraw, kv);
        unpack8(vraw, vv);
#pragma unroll
        for (int dir = 0; dir < 2; ++dir) {
            float a[8], c[8];
#pragma unroll
            for (int i = 0; i < 8; ++i) { const float bc = la[(dir * 64 + s) * 64 + seg + i]; a[i] = qv[i] * 0.125f * __expf(bc); c[i] = kv[i] * __expf(-bc); }
            *(u32x4*)(qi + (dir * 64 + s) * 72 + seg) = pack8(a);
            *(u32x4*)(ki + (dir * 64 + s) * 72 + seg) = pack8(c);
        }
#pragma unroll
        for (int i = 0; i < 8; ++i) vT[(seg + i) * 72 + s] = raw16(vraw, i);
#pragma unroll
        for (int i = 0; i < 2; ++i) {
            const int id = i * NT + t, dir = id >> 9, e = (id >> 3) & 63, sg = (id & 7) * 8;
            const bf16_t* src = ST + ((size_t)((b * 2 + dir) * NCI + gla_ci(dir, mc)) * 4 + h) * 4096 + e * 64 + sg;
            *(u32x4*)(sT + (dir * 64 + e) * 72 + sg) = *(const u32x4*)src;
        }
    }
    __syncthreads();
    {
        const int dir = w >> 2, nt = w & 3;
        bf16x8 bq[2];
#pragma unroll
        for (int ks = 0; ks < 2; ++ks) bq[ks] = *(const bf16x8*)(qi + (dir * 64 + nt * 16 + fr) * 72 + ks * 32 + fq * 8);
        f32x4 sa[4];
#pragma unroll
        for (int m = 0; m < 4; ++m) sa[m] = (f32x4){0.f, 0.f, 0.f, 0.f};
#pragma unroll
        for (int ks = 0; ks < 2; ++ks)
#pragma unroll
            for (int m = 0; m < 4; ++m) sa[m] = mfma16(*(const bf16x8*)(ki + (dir * 64 + m * 16 + fr) * 72 + ks * 32 + fq * 8), bq[ks], sa[m]);
        const int tt = nt * 16 + fr;
#pragma unroll
        for (int m = 0; m < 4; ++m)
#pragma unroll
            for (int j = 0; j < 4; ++j) { const int s = m * 16 + fq * 4 + j; const bool keep = dir ? (s >= tt) : (s <= tt); if (!keep) sa[m][j] = 0.f; }
        f32x4 oa[4];
#pragma unroll
        for (int et = 0; et < 4; ++et) oa[et] = (f32x4){0.f, 0.f, 0.f, 0.f};
#pragma unroll
        for (int k2 = 0; k2 < 2; ++k2) {
            u32x4 u; u.x = pk2(sa[2 * k2][0], sa[2 * k2][1]); u.y = pk2(sa[2 * k2][2], sa[2 * k2][3]); u.z = pk2(sa[2 * k2 + 1][0], sa[2 * k2 + 1][1]); u.w = pk2(sa[2 * k2 + 1][2], sa[2 * k2 + 1][3]);
            const bf16x8 pb = __builtin_bit_cast(bf16x8, u);
#pragma unroll
            for (int et = 0; et < 4; ++et) {
                const bf16x4 v0 = *(const bf16x4*)(vT + (et * 16 + fr) * 72 + (2 * k2) * 16 + fq * 4);
                const bf16x4 v1 = *(const bf16x4*)(vT + (et * 16 + fr) * 72 + (2 * k2 + 1) * 16 + fq * 4);
                oa[et] = mfma16(__builtin_shufflevector(v0, v1, 0, 1, 2, 3, 4, 5, 6, 7), pb, oa[et]);
            }
        }
#pragma unroll
        for (int ks = 0; ks < 2; ++ks)
#pragma unroll
            for (int et = 0; et < 4; ++et) oa[et] = mfma16(*(const bf16x8*)(sT + (dir * 64 + et * 16 + fr) * 72 + ks * 32 + fq * 8), bq[ks], oa[et]);
#pragma unroll
        for (int et = 0; et < 4; ++et)
            *(f32x4*)(O + (dir * 64 + tt) * 68 + et * 16 + fq * 4) = oa[et];
    }
    __syncthreads();
    {
        const int tok = t >> 3, seg = (t & 7) * 8;
        float ov[8], rv[8]; float ss = 0.f;
        { const f32x4 a0 = *(const f32x4*)(O + tok * 68 + seg), a1 = *(const f32x4*)(O + tok * 68 + seg + 4), b0 = *(const f32x4*)(O + (64 + tok) * 68 + seg), b1 = *(const f32x4*)(O + (64 + tok) * 68 + seg + 4);
          const f32x4 s0 = a0 + b0, s1 = a1 + b1; ov[0] = s0.x; ov[1] = s0.y; ov[2] = s0.z; ov[3] = s0.w; ov[4] = s1.x; ov[5] = s1.y; ov[6] = s1.z; ov[7] = s1.w; }
#pragma unroll
        for (int i = 0; i < 8; ++i) ss += ov[i] * ov[i];
        ss += dpp_xor1(ss); ss += dpp_xor2(ss); ss += __shfl_xor(ss, 4);
        const float rstd = rsqrtf(ss * (1.f / 64.f) + 1e-6f);
        unpack8(rraw, rv);
#pragma unroll
        for (int i = 0; i < 8; ++i) ov[i] = ov[i] * rstd * p.glag[l * 64 + seg + i] * silu_f(rv[i]);
        *(u32x4*)(MIX + (size_t)(row0 + tok) * DM + 768 + h * 64 + seg) = pack8(ov);
    }
}

constexpr int NPH = 19;
DEVI void run_phase(const Params& p, int ph, unsigned char* lds) {
    if (ph == 0) { prep_phase(p, lds); return; }
    const int l = (ph - 1) / 9, s = (ph - 1) % 9;
    const bool last = (l == 1);
    const float* MOD = (const float*)(p.ws + WS_MOD) + l * 3 * 6144;
    bf16_t* H = (bf16_t*)(p.ws + WS_H);
    float* XC = (float*)(p.ws + WS_XC);
    switch (s) {
    case 0: norm_phase(p, l, 0); break;
    case 1: { EpiInProj e{(bf16_t*)(p.ws + WS_P), (bf16_t*)(p.ws + WS_VTL), (bf16_t*)(p.ws + WS_VTC)};
              gemm_phase8(H, (const bf16_t*)(p.ws + WS_WIN + l * SZ_WIN), DM, 66, 9, e, lds);
              {
                  const int G = gridDim.x, rem = (66 * 9) % G, first = rem ? rem : 0, nidle = G - first;
                  if ((int)blockIdx.x >= first) prep_phase(p, lds, l == 0 ? 1 : 2, first, nidle);
              } } break;
    case 2: {
        const int nA = last ? 256 : 264, nCF = last ? 0 : 8, nF1 = 512, nG1 = 2 * NCI * 4;
        const int G = gridDim.x;
        { const float* rt = (const float*)(p.ws + WS_ROPE); float* rl = (float*)(lds + ROPE_LDS_OFF); for (int i = tidx(); i < 4096; i += NT) rl[i] = rt[i]; }
        for (int it = blockIdx.x; it < nA; it += G) attn_item(p, l, it, lds);
        for (int it = (blockIdx.x + G - (nA % G)) % G; it < nCF; it += G) cf_item(p, l, it, lds);
        int g1s, g1n, gstep = 1, f1a = 0, f1n = 0, f1x = -1, fstep = 1;
        const int bx = blockIdx.x;
        if (G == 256) {
            if (!last) {
                if (bx < 8) { g1s = 3 * bx; g1n = 3; f1a = bx; f1n = 1; }
                else if (bx < 16) { g1s = 24 + 4 * (bx - 8); g1n = 4; f1a = bx; f1n = 1; }
                else if (bx < 56) { g1s = 56 + 5 * (bx - 16); g1n = 5; }
                else { g1s = 256 + 4 * (bx - 56); g1n = 4; f1a = 16 + 2 * (bx - 56); f1n = 2; if (bx < 152) f1x = 416 + (bx - 56); }
            } else {
                if (bx < 32) { g1s = 5 * bx; g1n = 5; }
                else { g1s = 160 + 4 * (bx - 32); g1n = 4; f1a = 2 * (bx - 32); f1n = 2; if (bx < 96) f1x = 448 + (bx - 32); }
            }
        } else {
            f1a = (bx + G - ((nA + nCF) % G)) % G; fstep = G; f1n = f1a < nF1 ? (nF1 - 1 - f1a) / G + 1 : 0;
            g1s = (bx + G - ((nA + nCF + nF1) % G)) % G; gstep = G; g1n = g1s < nG1 ? (nG1 - 1 - g1s) / G + 1 : 0;
        }
        {
            const int ftot = f1n + (f1x >= 0 ? 1 : 0);
            u32x4 fa, fc;
            if (ftot > 0) f1_load(p, f1a, fa, fc);
            for (int j = 0; j < ftot; ++j) {
                const int cur = j < f1n ? f1a + j * fstep : f1x;
                const int nxt = j + 1 < f1n ? f1a + (j + 1) * fstep : (j + 1 < ftot ? f1x : -1);
                f1_item(p, cur, lds, fa, fc, nxt);
            }
        }
        for (int j = 0; j < g1n; ++j) g1_item(p, l, g1s + j * gstep, lds);
    } break;
    case 3: {
        const int nG2 = 128, nF2 = 1024, nF2c = last ? 0 : 32;
        const int G = gridDim.x;
        for (int it = blockIdx.x; it < nG2; it += G) g2_item(p, it);
        if (G == 256) {
            const int bx = blockIdx.x;
            const int first = bx * 4, cnt = 4;
            const bool hasc = bx >= 128 && (bx - 128) < nF2c;
            u32x4 fa, fc; f2_load(p, first, false, fa, fc);
            for (int j = 0; j < cnt; ++j) { const bool lastj = j + 1 == cnt; f2_item(p, l, first + j, lds, false, fa, fc, lastj ? (hasc ? bx - 128 : -1) : first + j + 1, lastj && hasc); }
            if (hasc) f2_item(p, l, bx - 128, lds, true, fa, fc, -1, false);
        } else {
            u32x4 fa, fc;
            for (int it = blockIdx.x; it < nF2; it += G) { f2_load(p, it, false, fa, fc); f2_item(p, l, it, lds, false, fa, fc, -1, false); }
            for (int it = blockIdx.x; it < nF2c; it += G) { f2_load(p, it, true, fa, fc); f2_item(p, l, it, lds, true, fa, fc, -1, false); }
        }
    } break;
    case 4: {
        const int nG3 = 2 * NCI * 4;
        {
            const int G = gridDim.x;
            auto nxt = [&](int it) { for (it += G; it < nG3; it += G) { if (!(last && ((it >> 2) % NCI) < 4)) return it; } return -1; };
            int it = (int)blockIdx.x - G; it = nxt(it);
            G3Pre pre;
            if (it >= 0) g3_load(p, it, pre);
            while (it >= 0) { const int nx = nxt(it); g3_item(p, l, it, lds, pre, nx); it = nx; }
        }
    } break;
    case 5: { EpiResid e{l == 0 ? p.x : p.out, l == 0 ? p.ctx : XC, p.out, XC, MOD, 2 * DM, (float*)(p.ws + WS_PART)};
              gemm_phase8((const bf16_t*)(p.ws + WS_MIX), (const bf16_t*)(p.ws + WS_WOUT + l * SZ_WOUT), DM, 64, 4, e, lds, last ? 0 : 4); } break;
    case 6: norm_phase(p, l, 1); break;
    case 7: { EpiSwiglu e{(bf16_t*)(p.ws + WS_HID)};
              gemm_phase8(H, (const bf16_t*)(p.ws + WS_WFI + l * SZ_WFI), DM, last ? 64 : 66, 22, e, lds); } break;
    case 8: { EpiResid e{p.out, XC, p.out, XC, MOD, 5 * DM, (float*)(p.ws + WS_PART)};
              gemm_phase8((const bf16_t*)(p.ws + WS_HID), (const bf16_t*)(p.ws + WS_WFO + l * SZ_WFO), FFH, 64, 4, e, lds, last ? 0 : 4); } break;
    }
}


#define XB_TMO      128
#define XB_XCNT(j)  (256  + 64 * (j))
#define XB_XSUB(j)  (1280 + 64 * (j))
#define XB_XGEN(j)  (2304 + 64 * (j))
#define XB_TOP      3328
#define XB_TOPGEN   3392
#define XCD_BAR_WORDS 3456
#define XB_SPIN_CAP (1u << 18)
DEVI unsigned xb_ld(unsigned* p) { return __hip_atomic_load(p, __ATOMIC_RELAXED, __HIP_MEMORY_SCOPE_AGENT); }
DEVI unsigned xb_add(unsigned* p, unsigned v) { return __hip_atomic_fetch_add(p, v, __ATOMIC_RELAXED, __HIP_MEMORY_SCOPE_AGENT); }
DEVI unsigned xb_xcc_id() { return (unsigned)__builtin_amdgcn_s_getreg((3 << 11) | 20) & 0xFu; }
#define XB_SPIN(cond, bar) do { unsigned _sp = 0; while (cond) { __builtin_amdgcn_s_sleep(1); \
    if ((++_sp & 255u) == 0u) { if (xb_ld(&(bar)[XB_TMO])) break; if (_sp > XB_SPIN_CAP) { atomicAdd(&(bar)[XB_TMO], 1u); break; } } } } while (0)
struct XcdBarrier { unsigned* bar; unsigned x; volatile __attribute__((address_space(3))) unsigned* st; };
DEVI XcdBarrier xcd_barrier_post(unsigned* bar, volatile __attribute__((address_space(3))) unsigned* st) {
    XcdBarrier b; b.bar = bar; b.x = xb_xcc_id(); b.st = st;
    if (threadIdx.x == 0) (void)xb_add(&bar[XB_XCNT(b.x)], 1u);
    return b;
}
DEVI void xcd_barrier_complete(unsigned* bar, unsigned x, unsigned& nloc, unsigned& nx) {
    const unsigned G = gridDim.x * gridDim.y * gridDim.z;
    unsigned sum, cnt, mine, sp = 0u;
    for (;;) {
        sum = 0u; cnt = 0u; mine = 0u;
#pragma unroll
        for (unsigned j = 0; j < 16; ++j) { const unsigned c = xb_ld(&bar[XB_XCNT(j)]); sum += c; cnt += (c > 0u) ? 1u : 0u; mine = (j == x) ? c : mine; }
        if (sum == G) break;
        __builtin_amdgcn_s_sleep(1);
        if ((++sp & 255u) == 0u) { if (xb_ld(&bar[XB_TMO])) break; if (sp > XB_SPIN_CAP) { atomicAdd(&bar[XB_TMO], 1u); break; } }
    }
    nloc = mine > 0u ? mine : 1u; nx = cnt > 0u ? cnt : 1u;
}
DEVI void xcd_barrier(const XcdBarrier& b) {
    asm volatile("s_waitcnt vmcnt(0)" ::: "memory");
    __syncthreads();
    if (threadIdx.x == 0) {
        unsigned* bar = b.bar;
        __builtin_amdgcn_s_waitcnt(0);
        unsigned nloc = b.st[0], nx = b.st[1];
        if (nloc == 0u) { xcd_barrier_complete(bar, b.x, nloc, nx); b.st[0] = nloc; b.st[1] = nx; }
        const unsigned old = xb_add(&bar[XB_XSUB(b.x)], 1u);
        const unsigned gen = old / nloc;
        if (old + 1u == (gen + 1u) * nloc) {
            __builtin_amdgcn_fence(__ATOMIC_RELEASE, "agent");
            asm volatile("s_waitcnt vmcnt(0)" ::: "memory");
            const unsigned og = xb_add(&bar[XB_TOP], 1u);
            const unsigned tg = og / nx;
            if (og + 1u == (tg + 1u) * nx) xb_add(&bar[XB_TOPGEN], 1u);
            else XB_SPIN(xb_ld(&bar[XB_TOPGEN]) == tg, bar);
            __builtin_amdgcn_fence(__ATOMIC_ACQUIRE, "agent");
            xb_add(&bar[XB_XGEN(b.x)], 1u);
            asm volatile("s_waitcnt vmcnt(0)" ::: "memory");
        } else {
            XB_SPIN(xb_ld(&bar[XB_XGEN(b.x)]) == gen, bar);
            __builtin_amdgcn_fence(__ATOMIC_ACQUIRE, "agent");
            asm volatile("s_waitcnt vmcnt(0)" ::: "memory");
        }
    }
    __syncthreads();
}

__global__ void __launch_bounds__(NT) mega_fwd(Params p) {
    extern __shared__ __attribute__((aligned(16))) unsigned char lds[];
    cg::grid_group grid = cg::this_grid();
    typedef const __attribute__((address_space(4))) Params* kparams_t;
    volatile __attribute__((address_space(3))) unsigned* xst = (volatile __attribute__((address_space(3))) unsigned*)((__attribute__((address_space(3))) unsigned char*)lds + (LDS_BYTES - 16));
    if (threadIdx.x == 0) { xst[0] = 0u; xst[1] = 0u; }
    __syncthreads();
    const bool fused = (p.ph_hi - p.ph_lo) > 1;
    XcdBarrier xb; xb.bar = (unsigned*)(p.ws + WS_BAR); xb.x = 0; xb.st = xst;
    if (fused) xb = xcd_barrier_post((unsigned*)(p.ws + WS_BAR), xst);
    for (int ph = p.ph_lo; ph < p.ph_hi; ++ph) {
        if (ph > p.ph_lo) { if (p.ph_lo < 0) grid.sync(); else xcd_barrier(xb); }
#if defined(__HIP_DEVICE_COMPILE__)
        kparams_t kp = (kparams_t)__builtin_amdgcn_kernarg_segment_ptr();
        asm volatile("" : "+s"(kp));
        Params lp;
        { const __attribute__((address_space(4))) unsigned long long* s8 = (const __attribute__((address_space(4))) unsigned long long*)kp; unsigned long long* d8 = (unsigned long long*)&lp;
#pragma unroll
          for (int i = 0; i < (int)(sizeof(Params) / 8); ++i) d8[i] = s8[i]; }
        run_phase(lp, ph, lds);
#endif
    }
}

extern "C" void kernel_launch(void* const* d_in, const int* in_sizes, int n_in, void* d_out, int out_size, void* d_ws, size_t ws_size, hipStream_t stream) {
    static int grid = 0;
    if (grid == 0) {
        if (ws_size < WS_TOTAL) { fprintf(stderr, "kernel_launch: workspace too small (%zu < %zu)\n", ws_size, (size_t)WS_TOTAL); grid = -1; return; }
        int dev = 0, cus = 0, per_cu = 0;
        hipGetDevice(&dev);
        hipDeviceGetAttribute(&cus, hipDeviceAttributeMultiprocessorCount, dev);
        if (hipFuncSetAttribute((const void*)mega_fwd, hipFuncAttributeMaxDynamicSharedMemorySize, LDS_BYTES) != hipSuccess) fprintf(stderr, "kernel_launch: hipFuncSetAttribute failed\n");
        if (hipOccupancyMaxActiveBlocksPerMultiprocessor(&per_cu, (const void*)mega_fwd, NT, LDS_BYTES) != hipSuccess || per_cu < 1) { fprintf(stderr, "kernel_launch: occupancy query gave %d\n", per_cu); per_cu = 1; }
        (void)hipGetLastError();
        grid = cus * per_cu;
        fprintf(stderr, "kernel_launch: grid %d (cus %d x %d)\n", grid, cus, per_cu);
    }
    if (grid < 0) return;
    (void)hipMemsetAsync((unsigned char*)d_ws + WS_BAR, 0, 16384, stream);
    Params p{};
    const float** f = (const float**)&p;
    for (int i = 0; i < 21; ++i) f[i] = (const float*)d_in[i];
    p.out = (float*)d_out; p.ws = (unsigned char*)d_ws;
#if N_LAUNCH_SPLIT
    for (int ph = 0; ph < NPH; ++ph) { p.ph_lo = ph; p.ph_hi = ph + 1; hipLaunchKernelGGL(mega_fwd, dim3(grid), dim3(NT), LDS_BYTES, stream, p); }
#else
    p.ph_lo = 0; p.ph_hi = NPH;
    void* args[] = {&p};
    hipError_t e = hipLaunchCooperativeKernel((const void*)mega_fwd, dim3(grid), dim3(NT), args, LDS_BYTES, stream);
    if (e != hipSuccess) fprintf(stderr, "kernel_launch: cooperative launch failed: %s (grid %d)\n", hipGetErrorString(e), grid);
#endif
}
```

```cpp
#include <hip/hip_runtime.h>
#include <hip/hip_cooperative_groups.h>
#include <cstdio>
#include <cstdint>
namespace cg = cooperative_groups;

typedef unsigned short bf16_t;
typedef short bf16x8 __attribute__((ext_vector_type(8)));
typedef short bf16x4 __attribute__((ext_vector_type(4)));
typedef float f32x4 __attribute__((ext_vector_type(4)));
typedef unsigned u32x4 __attribute__((ext_vector_type(4)));
typedef unsigned u32x2 __attribute__((ext_vector_type(2)));

#define DEVI __device__ __forceinline__
#ifndef N_LAUNCH_SPLIT
#define N_LAUNCH_SPLIT 0
#endif

constexpr int NT = 512;
constexpr int DM = 1024, SEQ = 8192, CTXL = 256;
constexpr int TOKL = 16384, TOKC = 512, TOK = 16896;
constexpr int INW = 2080, INWP = 2304, FFH = 2816;
constexpr int NCI = 132;
constexpr int LDS_BYTES = 147456;

constexpr size_t SZ_WIN = (size_t)INWP * DM * 2, SZ_WOUT = (size_t)DM * DM * 2, SZ_WFI = (size_t)2 * FFH * DM * 2, SZ_WFO = (size_t)DM * FFH * 2;
constexpr size_t WS_WIN = 0;
constexpr size_t WS_WOUT = WS_WIN + 2 * SZ_WIN;
constexpr size_t WS_WFI = WS_WOUT + 2 * SZ_WOUT;
constexpr size_t WS_WFO = WS_WFI + 2 * SZ_WFI;
constexpr size_t WS_MOD = WS_WFO + 2 * SZ_WFO;
constexpr size_t WS_ROPE = WS_MOD + 2 * 3 * 6144 * 4;
constexpr size_t WS_D128 = WS_ROPE + 2 * 128 * 16 * 4;
constexpr size_t WS_T64 = WS_D128 + 256 * 128 * 2;
constexpr size_t WS_MMT = WS_T64 + 128 * 128 * 2;
constexpr size_t WS_XC = WS_MMT + 2 * 4 * 64 * 128 * 2;
constexpr size_t WS_DEC = WS_XC + (size_t)TOKC * DM * 4;
constexpr size_t WS_H = WS_DEC + (size_t)2 * 2 * NCI * 4 * 64 * 4;
constexpr size_t WS_MIX = WS_H + (size_t)TOK * DM * 2;
constexpr size_t WS_P = WS_MIX + (size_t)TOK * DM * 2;
constexpr size_t WS_VTL = WS_P + (size_t)TOK * INWP * 2;
constexpr size_t WS_VTC = WS_VTL + (size_t)2 * 2 * 64 * SEQ * 2;
constexpr size_t WS_YP = WS_VTC + (size_t)2 * 2 * 64 * CTXL * 2;
constexpr size_t WS_UT = WS_YP + (size_t)2 * 4 * 128 * 2 * 64 * 64 * 2;
constexpr size_t WS_END = WS_UT + (size_t)2 * 2 * NCI * 4 * 4096 * 2;
constexpr size_t WS_BAR = WS_END;
constexpr size_t WS_PART = WS_BAR + 16384;
constexpr size_t WS_YPC = WS_PART + (size_t)4 * TOKC * DM * 4;
constexpr size_t WS_LA = WS_YPC + (size_t)2 * 4 * 4 * 2 * 64 * 64 * 2;
constexpr size_t WS_TOTAL = WS_LA + (size_t)2 * NCI * 4 * 2 * 64 * 64 * 2;
constexpr size_t WS_HID = WS_P;
static_assert(WS_HID + (size_t)TOK * FFH * 2 <= WS_UT, "HID overlay");
static_assert(WS_TOTAL <= 268435456ull, "workspace");

struct Params {
    const float *x, *c, *ctx, *c_ctx, *w_mod, *b_mod, *g1, *w_in, *qg, *kg, *sink, *wf, *wgf, *bgf, *wgb, *bgb, *glag, *w_out, *g2, *w_fi, *w_fo;
    float* out; unsigned char* ws;
    int ph_lo, ph_hi;
};

DEVI int tidx() { int t = threadIdx.x; asm volatile("" : "+v"(t)); return t; }
typedef __bf16 bf16v2 __attribute__((ext_vector_type(2)));
DEVI unsigned pk2(float lo, float hi) { bf16v2 v = {(__bf16)lo, (__bf16)hi}; return __builtin_bit_cast(unsigned, v); }
DEVI bf16_t f2bf(float f) { return (bf16_t)(pk2(f, 0.f) & 0xffffu); }
DEVI float bf2f(bf16_t h) { return __uint_as_float(((unsigned)h) << 16); }
DEVI float bflo(unsigned u) { return __uint_as_float(u << 16); }
DEVI float bfhi(unsigned u) { return __uint_as_float(u & 0xffff0000u); }
DEVI f32x4 mfma16(bf16x8 a, bf16x8 b, f32x4 c) { return __builtin_amdgcn_mfma_f32_16x16x32_bf16(a, b, c, 0, 0, 0); }
DEVI void unpack8(u32x4 u, float* v) { v[0] = bflo(u.x); v[1] = bfhi(u.x); v[2] = bflo(u.y); v[3] = bfhi(u.y); v[4] = bflo(u.z); v[5] = bfhi(u.z); v[6] = bflo(u.w); v[7] = bfhi(u.w); }
DEVI u32x4 pack8(const float* v) { u32x4 o; o.x = pk2(v[0], v[1]); o.y = pk2(v[2], v[3]); o.z = pk2(v[4], v[5]); o.w = pk2(v[6], v[7]); return o; }
DEVI float dpp_xor1(float x) { return __uint_as_float((unsigned)__builtin_amdgcn_mov_dpp((int)__float_as_uint(x), 0xB1, 0xF, 0xF, true)); }
DEVI float dpp_xor2(float x) { return __uint_as_float((unsigned)__builtin_amdgcn_mov_dpp((int)__float_as_uint(x), 0x4E, 0xF, 0xF, true)); }
DEVI float red_max_16_32(float x) {
    auto r = __builtin_amdgcn_permlane16_swap(__float_as_uint(x), __float_as_uint(x), false, false); x = fmaxf(__uint_as_float(r[0]), __uint_as_float(r[1]));
    auto q = __builtin_amdgcn_permlane32_swap(__float_as_uint(x), __float_as_uint(x), false, false); return fmaxf(__uint_as_float(q[0]), __uint_as_float(q[1]));
}
DEVI float red_sum_16_32(float x) {
    auto r = __builtin_amdgcn_permlane16_swap(__float_as_uint(x), __float_as_uint(x), false, false); x = __uint_as_float(r[0]) + __uint_as_float(r[1]);
    auto q = __builtin_amdgcn_permlane32_swap(__float_as_uint(x), __float_as_uint(x), false, false); return __uint_as_float(q[0]) + __uint_as_float(q[1]);
}
DEVI bf16_t raw16(const u32x4 u, int i) { const unsigned w = (i >> 1) == 0 ? u.x : ((i >> 1) == 1 ? u.y : ((i >> 1) == 2 ? u.z : u.w)); return (bf16_t)((i & 1) ? (w >> 16) : (w & 0xffffu)); }
DEVI float silu_f(float v) { return v * __builtin_amdgcn_rcpf(1.f + __builtin_amdgcn_exp2f(v * -1.44269504f)); }

DEVI void transpose_tile(const float* __restrict__ W, int N, int Nvalid, bf16_t* __restrict__ WT, int Kdst, int k0, int n0, int mode, float* tile) {
    const int t = tidx();
    __syncthreads();
    {
        const int c4 = (t & 63) * 4;
        float4 v[8];
#pragma unroll
        for (int i = 0; i < 8; ++i) { const int kk = (t >> 6) + 8 * i; v[i] = make_float4(0.f, 0.f, 0.f, 0.f); if (n0 + c4 < Nvalid) v[i] = *(const float4*)(W + (size_t)(k0 + kk) * N + n0 + c4); }
#pragma unroll
        for (int i = 0; i < 8; ++i) { const int kk = (t >> 6) + 8 * i; tile[kk * 257 + c4 + 0] = v[i].x; tile[kk * 257 + c4 + 1] = v[i].y; tile[kk * 257 + c4 + 2] = v[i].z; tile[kk * 257 + c4 + 3] = v[i].w; }
    }
    __syncthreads();
    const int nn = t >> 1, ks = (t & 1) * 32;
    const int n = n0 + nn;
    int orow = n;
    if (mode == 1) { if (n < FFH) orow = (n >> 7) * 256 + (n & 127); else { const int j = n - FFH; orow = (j >> 7) * 256 + 128 + (j & 127); } }
    { const int q5 = orow & 31; orow = (orow & ~31) + ((q5 >> 2) & 1) * 16 + (q5 >> 3) * 4 + (q5 & 3); }
#pragma unroll
    for (int q = 0; q < 4; ++q) {
        float v[8];
#pragma unroll
        for (int j = 0; j < 8; ++j) v[j] = tile[(ks + q * 8 + j) * 257 + nn];
        *(u32x4*)(WT + (size_t)orow * Kdst + k0 + ks + q * 8) = pack8(v);
    }
}

DEVI void prep_phase(const Params& p, unsigned char* lds, const int lsel = 0, const int bid0 = 0, const int nblk = 0) {
    const int t = tidx();
    constexpr int PER_L = 144 + 64 + 352 + 176;
    constexpr int N_MOD = 192, N_TAB = 9;
    const int NITEMS = N_MOD + N_TAB + (lsel == 0 ? 208 : (lsel == 1 ? 736 : 528));
    float* fl = (float*)lds;
    const int it0 = lsel ? N_MOD + N_TAB + ((int)blockIdx.x - bid0) : (int)blockIdx.x, itstep = lsel ? nblk : (int)gridDim.x;
    for (int it = it0; it < NITEMS; it += itstep) {
        if (it < N_MOD) {
            const int l = it / 96, j0 = (it % 96) * 64;
            float* sc = fl; float* red = fl + 3072;
            __syncthreads();
            for (int i = t; i < 3072; i += NT) { const int v = i >> 10, k = i & 1023; const float cv = v < 2 ? p.c[v * 1024 + k] : p.c_ctx[k]; sc[i] = cv / (1.f + expf(-cv)); }
            __syncthreads();
            const int jj = t & 63, kg = t >> 6;
            const float* w = p.w_mod + (size_t)l * 1024 * 6144 + j0 + jj;
            float a0 = 0.f, a1 = 0.f, a2 = 0.f;
#pragma unroll 1
            for (int k0 = kg * 128; k0 < kg * 128 + 128; k0 += 32) {
                float wv[32];
#pragma unroll
                for (int i = 0; i < 32; ++i) wv[i] = w[(size_t)(k0 + i) * 6144];
#pragma unroll
                for (int i = 0; i < 32; ++i) { a0 += sc[k0 + i] * wv[i]; a1 += sc[1024 + k0 + i] * wv[i]; a2 += sc[2048 + k0 + i] * wv[i]; }
            }
            red[(kg * 3 + 0) * 64 + jj] = a0; red[(kg * 3 + 1) * 64 + jj] = a1; red[(kg * 3 + 2) * 64 + jj] = a2;
            __syncthreads();
            if (t < 192) {
                const int v = t >> 6, j = t & 63; float s = 0.f;
#pragma unroll
                for (int g = 0; g < 8; ++g) s += red[(g * 3 + v) * 64 + j];
                ((float*)(p.ws + WS_MOD))[(l * 3 + v) * 6144 + j0 + j] = s + p.b_mod[l * 6144 + j0 + j];
            }
        } else if (it < N_MOD + N_TAB) {
            const int ti = it - N_MOD;
            if (ti == 0) {
                float* rope = (float*)(p.ws + WS_ROPE);
                for (int i = t; i < 128 * 16; i += NT) { const int pos = i >> 4, f = i & 15; const float inv = powf(10000.f, -(float)(2 * f) / 32.f); const float ang = (float)pos * inv; rope[i] = cosf(ang); rope[2048 + i] = sinf(ang); }
                bf16_t* d128 = (bf16_t*)(p.ws + WS_D128);
                for (int i = t; i < 256 * 128; i += NT) { const int r = i >> 7, n1 = i & 127; const int part = (r >> 4) & 1, k1 = (r >> 5) * 16 + (r & 15); const int m = (n1 * k1) & 127; const float a = (float)m / 64.f; d128[i] = f2bf(part == 0 ? cospif(a) : -sinpif(a)); }
                bf16_t* t64 = (bf16_t*)(p.ws + WS_T64);
                for (int i = t; i < 128 * 128; i += NT) { const int r = i >> 7, kk = i & 127; const int mt = r >> 4, po = mt & 1, k2 = (mt >> 1) * 16 + (r & 15), part = kk >> 6, n2 = kk & 63; const int m = (n2 * k2) & 63; const float a = (float)m / 32.f; const float cs = cospif(a), sn = sinpif(a);
                    t64[i] = f2bf(po == 0 ? (part == 0 ? cs : sn) : (part == 0 ? -sn : cs)); }
            } else {
                const int l = (ti - 1) >> 2, g = (ti - 1) & 3;
                const float* wf = p.wf + (size_t)(l * 4 + g) * 4096;
                bf16_t* mmt = (bf16_t*)(p.ws + WS_MMT) + (size_t)(l * 4 + g) * 8192;
                const float nrm = 1.0f / sqrtf(8192.f * 64.f);
                __syncthreads();
                if (t < 64) { fl[t] = cospif((float)t / 32.f); fl[64 + t] = sinpif((float)t / 32.f); }
                for (int i = t; i < 4096; i += NT) fl[128 + i] = wf[i];
                __syncthreads();
                for (int i = t; i < 8192; i += NT) { const int e = i >> 7, cp = i & 127, part = cp >> 6, c = cp & 63; float s = 0.f;
#pragma unroll 8
                    for (int e0 = 0; e0 < 64; ++e0) s += fl[part * 64 + ((c * e0) & 63)] * fl[128 + e0 * 64 + e];
                    mmt[i] = f2bf(s * nrm); }
            }
        } else {
            int r = it - N_MOD - N_TAB; int l = 0;
            if (lsel == 1) { if (r < 528) r += 208; else { r -= 528; l = 1; } }
            else if (lsel == 2) { r += 208; l = 1; }
            if (r < 144) { transpose_tile(p.w_in + (size_t)l * DM * INW, INW, INW, (bf16_t*)(p.ws + WS_WIN + l * SZ_WIN), DM, (r / 9) * 64, (r % 9) * 256, 0, fl); continue; } r -= 144;
            if (r < 64) { transpose_tile(p.w_out + (size_t)l * DM * DM, DM, DM, (bf16_t*)(p.ws + WS_WOUT + l * SZ_WOUT), DM, (r / 4) * 64, (r % 4) * 256, 0, fl); continue; } r -= 64;
            if (r < 352) { transpose_tile(p.w_fi + (size_t)l * DM * 2 * FFH, 2 * FFH, 2 * FFH, (bf16_t*)(p.ws + WS_WFI + l * SZ_WFI), DM, (r / 22) * 64, (r % 22) * 256, 1, fl); continue; } r -= 352;
            transpose_tile(p.w_fo + (size_t)l * FFH * DM, DM, DM, (bf16_t*)(p.ws + WS_WFO + l * SZ_WFO), FFH, (r / 4) * 64, (r % 4) * 256, 0, fl);
        }
    }
}

DEVI void norm_phase(const Params& p, int l, int which) {
    const int lane = tidx() & 63, wave = tidx() >> 6;
    const int nrows = (which == 1 && l == 1) ? TOKL : TOK;
    const float* MOD = (const float*)(p.ws + WS_MOD);
    const float* XC = (const float*)(p.ws + WS_XC);
    bf16_t* H = (bf16_t*)(p.ws + WS_H);
    const float* g = (which ? p.g2 : p.g1) + l * DM;
    for (int r = blockIdx.x * 8 + wave; r < nrows; r += gridDim.x * 8) {
        const float* src; int vec;
        if (r < TOKL) { src = ((which == 0 && l == 0) ? p.x : p.out) + (size_t)r * DM; vec = r >> 13; }
        else { const int rc = r - TOKL; src = ((which == 0 && l == 0) ? p.ctx : XC) + (size_t)rc * DM; vec = 2; }
        const float* mod = MOD + (l * 3 + vec) * 6144;
        const float* sh = mod + (which ? 3 * DM : 0);
        const float* sc = mod + (which ? 4 * DM : DM);
        f32x4 v[4]; float ss = 0.f;
        const bool fold = (r >= TOKL) && ((which == 1 && l == 0) || (which == 0 && l == 1));
#pragma unroll
        for (int j = 0; j < 4; ++j) {
            v[j] = *(const f32x4*)(src + j * 256 + lane * 4);
            if (fold) {
                const float* pb = (const float*)(p.ws + WS_PART) + (size_t)(r - TOKL) * DM + j * 256 + lane * 4;
#pragma unroll
                for (int s = 0; s < 4; ++s) v[j] += *(const f32x4*)(pb + (size_t)s * TOKC * DM);
                *(f32x4*)((float*)(p.ws + WS_XC) + (size_t)(r - TOKL) * DM + j * 256 + lane * 4) = v[j];
            }
            ss += v[j].x * v[j].x + v[j].y * v[j].y + v[j].z * v[j].z + v[j].w * v[j].w;
        }
#pragma unroll
        for (int o = 1; o < 64; o <<= 1) ss += __shfl_xor(ss, o);
        const float rstd = rsqrtf(ss * (1.f / DM) + 1e-6f);
#pragma unroll
        for (int j = 0; j < 4; ++j) {
            const int k = j * 256 + lane * 4;
            const f32x4 gv = *(const f32x4*)(g + k), sv = *(const f32x4*)(sc + k), hv = *(const f32x4*)(sh + k);
            const f32x4 y = (v[j] * rstd) * gv * (sv + 1.f) + hv;
            u32x2 o; o.x = pk2(y.x, y.y); o.y = pk2(y.z, y.w);
            *(u32x2*)(H + (size_t)r * DM + k) = o;
            if (which == 0 && l == 0 && r >= TOKL) *(f32x4*)((float*)(p.ws + WS_XC) + (size_t)(r - TOKL) * DM + k) = v[j];
        }
    }
}

template <class Epi>
DEVI void gemm_phase(const bf16_t* __restrict__ A, const bf16_t* __restrict__ Bt, int K, int nM, int nN, const Epi& epi, unsigned char* lds) {
    bf16_t* As = (bf16_t*)lds; bf16_t* Bs = As + 256 * 72;
    const int t = tidx(), lane = t & 63, wid = t >> 6, wr = wid >> 2, wc = wid & 3, fr = lane & 15, fq = lane >> 4;
    const int ntile = nM * nN;
    for (int tile = blockIdx.x; tile < ntile; tile += gridDim.x) {
        const int pm = tile / nN, pn = tile % nN;
        f32x4 acc[2][2][4][2];
#pragma unroll
        for (int ai = 0; ai < 2; ++ai)
#pragma unroll
            for (int bj = 0; bj < 2; ++bj)
#pragma unroll
                for (int m = 0; m < 4; ++m)
#pragma unroll
                    for (int n = 0; n < 2; ++n) acc[ai][bj][m][n] = (f32x4){0.f, 0.f, 0.f, 0.f};
        const bf16_t* Ab = A + (size_t)pm * 256 * K; const bf16_t* Bb = Bt + (size_t)pn * 256 * K;
        for (int k0 = 0; k0 < K; k0 += 64) {
            u32x4 ra[4], rb[4];
#pragma unroll
            for (int i = 0; i < 4; ++i) { const int id = i * NT + t, row = id >> 3, seg = id & 7; ra[i] = *(const u32x4*)(Ab + (size_t)row * K + k0 + seg * 8); rb[i] = *(const u32x4*)(Bb + (size_t)row * K + k0 + seg * 8); }
            __syncthreads();
#pragma unroll
            for (int i = 0; i < 4; ++i) { const int id = i * NT + t, row = id >> 3, seg = id & 7; *(u32x4*)(As + row * 72 + seg * 8) = ra[i]; *(u32x4*)(Bs + row * 72 + seg * 8) = rb[i]; }
            __syncthreads();
#pragma unroll
            for (int ks = 0; ks < 2; ++ks) {
                bf16x8 af[2][4], bfg[2][2];
#pragma unroll
                for (int ai = 0; ai < 2; ++ai)
#pragma unroll
                    for (int m = 0; m < 4; ++m) af[ai][m] = *(const bf16x8*)(As + (ai * 128 + wr * 64 + m * 16 + fr) * 72 + ks * 32 + fq * 8);
#pragma unroll
                for (int bj = 0; bj < 2; ++bj)
#pragma unroll
                    for (int n = 0; n < 2; ++n) bfg[bj][n] = *(const bf16x8*)(Bs + (bj * 128 + wc * 32 + n * 16 + fr) * 72 + ks * 32 + fq * 8);
#pragma unroll
                for (int ai = 0; ai < 2; ++ai)
#pragma unroll
                    for (int bj = 0; bj < 2; ++bj)
#pragma unroll
                        for (int m = 0; m < 4; ++m)
#pragma unroll
                            for (int n = 0; n < 2; ++n) acc[ai][bj][m][n] = mfma16(bfg[bj][n], af[ai][m], acc[ai][bj][m][n]);
            }
        }
        epi(acc, pm, pn, wr, wc, fr, fq);
    }
}


typedef __attribute__((address_space(3))) unsigned char ldsb_t;
typedef __attribute__((address_space(3))) unsigned ldsu_t;
DEVI int g8_lds_byte(int r, int c) { const int st = (r >> 4) * 2 + (c >> 5), rr = r & 15, cc = c & 31, ob = rr * 64 + cc * 2; return st * 1024 + (ob ^ (((ob >> 9) & 1) << 5)); }
DEVI void g8_stage_rc(int b, int& R, int& C) { const int st = b / 1024, sb = b % 1024, swz = sb ^ (((sb >> 9) & 1) << 5); R = (st >> 1) * 16 + swz / 64; C = (st & 1) * 32 + (swz % 64) / 2; }
#define G8_SA(b, h) (shm + ((b) * 2 + (h)) * 16384)
#define G8_SB(b, h) (shm + (4 + (b) * 2 + (h)) * 16384)
#define G8_STAGE(Pp, BASE, br, kt) do { const char* _g = (const char*)((BASE) + (long)(br) * K + (long)(kt) * 64); \
    __builtin_amdgcn_global_load_lds((const unsigned*)(_g + so0), (ldsu_t*)((Pp) + wdst), 16, 0, 0); \
    __builtin_amdgcn_global_load_lds((const unsigned*)(_g + (size_t)128 * K + so0), (ldsu_t*)((Pp) + wdst + 8192), 16, 0, 0); } while (0)
#define G8_LDA(b, h) _Pragma("unroll") for (int m = 0; m < 4; ++m) _Pragma("unroll") for (int k = 0; k < 2; ++k) At[m][k] = *(const __attribute__((address_space(3))) bf16x8*)(G8_SA(b, h) + aoff + m * 2048 + k * 1024)
#define G8_LDB(dst, b, h) _Pragma("unroll") for (int n = 0; n < 2; ++n) _Pragma("unroll") for (int k = 0; k < 2; ++k) dst[n][k] = *(const __attribute__((address_space(3))) bf16x8*)(G8_SB(b, h) + boff + n * 2048 + k * 1024)
#define G8_MMA(ai, bj, Bx) do { __builtin_amdgcn_s_setprio(1); \
    _Pragma("unroll") for (int m = 0; m < 4; ++m) _Pragma("unroll") for (int n = 0; n < 2; ++n) _Pragma("unroll") for (int k = 0; k < 2; ++k) \
        acc[ai][bj][m][n] = __builtin_amdgcn_mfma_f32_16x16x32_bf16(Bx[n][k], At[m][k], acc[ai][bj][m][n], 0, 0, 0); \
    __builtin_amdgcn_s_setprio(0); } while (0)
#define G8_WV(n) asm volatile("s_waitcnt vmcnt(" #n ")" ::: "memory")
#define G8_WL(n) asm volatile("s_waitcnt lgkmcnt(" #n ")" ::: "memory")
#define G8_BAR __builtin_amdgcn_s_barrier()
#define G8_SCHED __builtin_amdgcn_sched_barrier(0)

template <class Epi>
DEVI void gemm_phase8(const bf16_t* __restrict__ A, const bf16_t* __restrict__ Bt, const int K, const int nM, const int nN, const Epi& epi, unsigned char* lds, const int nsplit = 0) {
    ldsb_t* shm = (ldsb_t*)lds;
    const int t = tidx(), lane = t & 63, wid = t >> 6, wr = wid >> 2, wc = wid & 3, fr = lane & 15, fq = lane >> 4;
    unsigned so0;
    { int r, c; g8_stage_rc(t * 16, r, c); so0 = (unsigned)(r * K + c) * 2u; }
    const int wdst = __builtin_amdgcn_readfirstlane(wid * 1024);
    const int loff = g8_lds_byte(fr, fq * 8);
    const int aoff = loff + wr * 8192, boff = loff + wc * 4096;
    const int nwg = nM * nN, G = gridDim.x, ntk = K / 64;
    const int nunits = nwg + 2 * nN * nsplit;
    auto decode = [&](long L, int& pm, int& pn, int& kbeg, int& nt, int& part) {
        kbeg = 0; nt = ntk; part = -1;
        if (L < nwg) {
            int wgid = (int)L; { const int q = nwg / 8, r = nwg % 8, xcd = wgid % 8, off = wgid / 8; wgid = (xcd < r ? xcd * (q + 1) : r * (q + 1) + (xcd - r) * q) + off; }
            const int nig = 8 * nN, gid = wgid / nig, fm = gid * 8, gsz = (nM - fm) < 8 ? (nM - fm) : 8;
            pm = fm + ((wgid % nig) % gsz); pn = (wgid % nig) / gsz;
        } else {
            const int v = (int)L - nwg, sp = v % nsplit, tl = v / nsplit;
            pm = 64 + tl / nN; pn = tl % nN; part = sp;
            const int base = (ntk / nsplit) & ~1, extra = (ntk - base * nsplit) / 2;
            nt = base + (sp < extra ? 2 : 0); kbeg = sp * base + 2 * (sp < extra ? sp : extra);
        }
    };
    int pm = 0, pn = 0, kbeg = 0, nt = ntk, part = -1;
    if ((long)blockIdx.x >= nunits) return;
    decode(blockIdx.x, pm, pn, kbeg, nt, part);
    const bf16_t* Au = A + (size_t)pm * 256 * K + (size_t)kbeg * 64; const bf16_t* Bu = Bt + (size_t)pn * 256 * K + (size_t)kbeg * 64;
    f32x4 acc[2][2][4][2];
#pragma unroll
    for (int ai = 0; ai < 2; ++ai)
#pragma unroll
        for (int bj = 0; bj < 2; ++bj)
#pragma unroll
            for (int m = 0; m < 4; ++m)
#pragma unroll
                for (int n = 0; n < 2; ++n) acc[ai][bj][m][n] = (f32x4){0.f, 0.f, 0.f, 0.f};
    bf16x8 At[4][2], B0[2][2], B1[2][2];
    G8_WV(0);
    G8_STAGE(G8_SB(0, 0), Bu, 0, 0); G8_STAGE(G8_SB(0, 1), Bu, 128, 0); G8_STAGE(G8_SA(0, 0), Au, 0, 0); G8_STAGE(G8_SA(0, 1), Au, 128, 0);
    if (wr == 1) G8_BAR;
    G8_WV(2); G8_BAR;
    G8_STAGE(G8_SB(1, 0), Bu, 0, 1); G8_STAGE(G8_SA(1, 0), Au, 0, 1); G8_STAGE(G8_SB(1, 1), Bu, 128, 1);
    G8_WV(6); G8_BAR;
    for (int it = 0;; ++it) {
        int npm = pm, npn = pn, nkbeg = kbeg, nnt = nt, npart = part;
        const long Ln = (long)(it + 1) * G + blockIdx.x; const bool has_next = Ln < nunits;
        if (has_next) decode(Ln, npm, npn, nkbeg, nnt, npart);
        const bf16_t* nAu = has_next ? A + (size_t)npm * 256 * K + (size_t)nkbeg * 64 : Au; const bf16_t* nBu = has_next ? Bt + (size_t)npn * 256 * K + (size_t)nkbeg * 64 : Bu;
        for (int kt = 0; kt < nt; kt += 2) {
            const bool lastk = (kt == nt - 2);
            const bf16_t* A2 = lastk ? nAu : Au; const bf16_t* B2 = lastk ? nBu : Bu; const int k2 = lastk ? 0 : kt + 2;
            G8_LDB(B0, 0, 0); G8_LDB(B1, 0, 1); G8_SCHED; G8_LDA(0, 0); G8_STAGE(G8_SA(1, 1), Au, 128, kt + 1);
            G8_WV(8); G8_WL(0); G8_BAR; G8_MMA(0, 0, B0); G8_MMA(0, 1, B1); G8_BAR; G8_SCHED;
            G8_LDA(0, 1); G8_STAGE(G8_SB(0, 0), B2, 0, k2); G8_STAGE(G8_SB(0, 1), B2, 128, k2); G8_STAGE(G8_SA(0, 0), A2, 0, k2);
            G8_WV(8); G8_WL(0); G8_BAR; G8_MMA(1, 0, B0); G8_MMA(1, 1, B1); G8_BAR; G8_SCHED;
            G8_LDB(B0, 1, 0); G8_LDB(B1, 1, 1); G8_SCHED; G8_LDA(1, 0); G8_STAGE(G8_SA(0, 1), A2, 128, k2);
            G8_WV(8); G8_WL(0); G8_BAR; G8_MMA(0, 0, B0); G8_MMA(0, 1, B1); G8_BAR; G8_SCHED;
            G8_LDA(1, 1); G8_STAGE(G8_SB(1, 0), B2, 0, k2 + 1); G8_STAGE(G8_SB(1, 1), B2, 128, k2 + 1); G8_STAGE(G8_SA(1, 0), A2, 0, k2 + 1);
            G8_WV(8); G8_WL(0); G8_BAR; G8_MMA(1, 0, B0); G8_MMA(1, 1, B1); G8_BAR; G8_SCHED;
        }
        if (wr == 0) G8_BAR;
        epi(acc, pm, pn, wr, wc, fr, fq, part);
        if (!has_next) break;
#pragma unroll
        for (int ai = 0; ai < 2; ++ai)
#pragma unroll
            for (int bj = 0; bj < 2; ++bj)
#pragma unroll
                for (int m = 0; m < 4; ++m)
#pragma unroll
                    for (int n = 0; n < 2; ++n) acc[ai][bj][m][n] = (f32x4){0.f, 0.f, 0.f, 0.f};
        pm = npm; pn = npn; kbeg = nkbeg; nt = nnt; part = npart; Au = nAu; Bu = nBu;
        if (wr == 1) G8_BAR;
    }
    G8_WV(0);
    G8_BAR;
}


struct EpiInProj {
    bf16_t* P; bf16_t* VTL; bf16_t* VTC;
    DEVI void operator()(const f32x4 (&acc)[2][2][4][2], int pm, int pn, int wr, int wc, int fr, int fq, int part = -1) const {
#pragma unroll
        for (int ai = 0; ai < 2; ++ai)
#pragma unroll
            for (int m = 0; m < 4; ++m) {
                const int r = pm * 256 + ai * 128 + wr * 64 + m * 16 + fr;
#pragma unroll
                for (int bj = 0; bj < 2; ++bj) {
                    const int c = pn * 256 + bj * 128 + wc * 32 + fq * 8;
                    const f32x4 v0 = acc[ai][bj][m][0], v1 = acc[ai][bj][m][1];
                    if (pn == 2 && bj == 1) {
                        const int di = c - 640, kvh = di >> 6, d = di & 63;
                        bf16_t* dst; int stride;
                        if (r < TOKL) { const int b = r >> 13, tt = r & 8191; dst = VTL + ((size_t)((b * 2 + kvh) * 64 + d)) * SEQ + tt; stride = SEQ; }
                        else { const int rc = r - TOKL, b = rc >> 8, tt = rc & 255; dst = VTC + ((size_t)((b * 2 + kvh) * 64 + d)) * CTXL + tt; stride = CTXL; }
                        dst[0] = f2bf(v0.x); dst[stride] = f2bf(v0.y); dst[2 * stride] = f2bf(v0.z); dst[3 * stride] = f2bf(v0.w);
                        dst[4 * stride] = f2bf(v1.x); dst[5 * stride] = f2bf(v1.y); dst[6 * stride] = f2bf(v1.z); dst[7 * stride] = f2bf(v1.w);
                    } else {
                        u32x4 o; o.x = pk2(v0.x, v0.y); o.y = pk2(v0.z, v0.w); o.z = pk2(v1.x, v1.y); o.w = pk2(v1.z, v1.w);
                        *(u32x4*)(P + (size_t)r * INWP + c) = o;
                    }
                }
            }
    }
};
struct EpiResid {
    const float* baseL; const float* baseC; float* outL; float* outC; const float* mod; int goff; float* partbuf;
    DEVI void operator()(const f32x4 (&acc)[2][2][4][2], int pm, int pn, int wr, int wc, int fr, int fq, int part = -1) const {
        const int vec = pm < 32 ? 0 : (pm < 64 ? 1 : 2);
        const int r0 = pm * 256 + wr * 64 + fr, c0 = pn * 256 + wc * 32 + fq * 8;
        const float* gt = mod + vec * 6144 + goff + c0;
        f32x4 gv[2][2];
#pragma unroll
        for (int bj = 0; bj < 2; ++bj)
#pragma unroll
            for (int n = 0; n < 2; ++n) gv[bj][n] = *(const f32x4*)(gt + bj * 128 + n * 4);
        if (part >= 0) {
#pragma unroll
            for (int ai = 0; ai < 2; ++ai)
#pragma unroll
                for (int m = 0; m < 4; ++m)
#pragma unroll
                    for (int bj = 0; bj < 2; ++bj)
#pragma unroll
                        for (int n = 0; n < 2; ++n)
                            *(f32x4*)(partbuf + ((size_t)part * TOKC + (r0 + ai * 128 + m * 16 - TOKL)) * DM + c0 + bj * 128 + n * 4) = gv[bj][n] * acc[ai][bj][m][n];
            return;
        }
        const float* base = pm < 64 ? baseL + (size_t)r0 * DM + c0 : baseC + (size_t)(r0 - TOKL) * DM + c0;
        float* dst = pm < 64 ? outL + (size_t)r0 * DM + c0 : outC + (size_t)(r0 - TOKL) * DM + c0;
#pragma unroll
        for (int ai = 0; ai < 2; ++ai) {
            f32x4 bv[4][2][2];
#pragma unroll
            for (int m = 0; m < 4; ++m)
#pragma unroll
                for (int bj = 0; bj < 2; ++bj)
#pragma unroll
                    for (int n = 0; n < 2; ++n) bv[m][bj][n] = *(const f32x4*)(base + (size_t)(ai * 128 + m * 16) * DM + bj * 128 + n * 4);
#pragma unroll
            for (int m = 0; m < 4; ++m)
#pragma unroll
                for (int bj = 0; bj < 2; ++bj)
#pragma unroll
                    for (int n = 0; n < 2; ++n) *(f32x4*)(dst + (size_t)(ai * 128 + m * 16) * DM + bj * 128 + n * 4) = bv[m][bj][n] + gv[bj][n] * acc[ai][bj][m][n];
        }
    }
};
struct EpiSwiglu {
    bf16_t* HID;
    DEVI void operator()(const f32x4 (&acc)[2][2][4][2], int pm, int pn, int wr, int wc, int fr, int fq, int part = -1) const {
#pragma unroll
        for (int ai = 0; ai < 2; ++ai)
#pragma unroll
            for (int m = 0; m < 4; ++m) {
                const int r = pm * 256 + ai * 128 + wr * 64 + m * 16 + fr;
                const int c = pn * 128 + wc * 32 + fq * 8;
                const f32x4 g0 = acc[ai][0][m][0], u0 = acc[ai][1][m][0], g1 = acc[ai][0][m][1], u1 = acc[ai][1][m][1];
                u32x4 o; o.x = pk2(silu_f(g0.x) * u0.x, silu_f(g0.y) * u0.y); o.y = pk2(silu_f(g0.z) * u0.z, silu_f(g0.w) * u0.w);
                o.z = pk2(silu_f(g1.x) * u1.x, silu_f(g1.y) * u1.y); o.w = pk2(silu_f(g1.z) * u1.z, silu_f(g1.w) * u1.w);
                *(u32x4*)(HID + (size_t)r * FFH + c) = o;
            }
    }
};

constexpr int ROPE_LDS_OFF = 114688;
DEVI void stage_norm_rope(const u32x4 raw, int row, int seg, const float* __restrict__ gn, bool rope, int pos, const float* ropel, float scale, bf16_t* dst) {
    float v[8]; unpack8(raw, v);
    float ss = 0.f;
#pragma unroll
    for (int j = 0; j < 8; ++j) ss += v[j] * v[j];
    ss += dpp_xor1(ss); ss += dpp_xor2(ss); ss += __shfl_xor(ss, 4);
    const float rstd = rsqrtf(ss * (1.f / 64.f) + 1e-6f);
    const f32x4 g0 = *(const f32x4*)(gn + seg * 8), g1 = *(const f32x4*)(gn + seg * 8 + 4);
    const float gg[8] = {g0.x, g0.y, g0.z, g0.w, g1.x, g1.y, g1.z, g1.w};
#pragma unroll
    for (int j = 0; j < 8; ++j) v[j] = v[j] * rstd * gg[j];
    float o[8];
    if (rope) {
        const int ap = (seg < 4) ? (pos >> 6) : (pos & 63);
        const float* tb = ropel + ap * 16 + (seg & 1) * 8;
        const f32x4 c0 = *(const f32x4*)tb, c1 = *(const f32x4*)(tb + 4), s0 = *(const f32x4*)(tb + 2048), s1 = *(const f32x4*)(tb + 2052);
        const float cs[8] = {c0.x, c0.y, c0.z, c0.w, c1.x, c1.y, c1.z, c1.w}, sn[8] = {s0.x, s0.y, s0.z, s0.w, s1.x, s1.y, s1.z, s1.w};
#pragma unroll
        for (int j = 0; j < 8; ++j) { const float pv = dpp_xor2(v[j]); o[j] = ((seg & 2) ? (v[j] * cs[j] + pv * sn[j]) : (v[j] * cs[j] - pv * sn[j])) * scale; }
    } else {
#pragma unroll
        for (int j = 0; j < 8; ++j) o[j] = v[j] * scale;
    }
    *(u32x4*)(dst + row * 72 + seg * 8) = pack8(o);
}

DEVI void attn_item(const Params& p, int l, int item, unsigned char* lds) {
    const int t = tidx(), lane = t & 63, wid = t >> 6, fr = lane & 15, fq = lane >> 4;
    const bf16_t* P = (const bf16_t*)(p.ws + WS_P);
    const bf16_t* VTL = (const bf16_t*)(p.ws + WS_VTL);
    const bf16_t* VTC = (const bf16_t*)(p.ws + WS_VTC);
    bf16_t* MIX = (bf16_t*)(p.ws + WS_MIX);
    const float* ropel = (const float*)(lds + ROPE_LDS_OFF);
    const float* qg = p.qg + l * 64; const float* kgn = p.kg + l * 64;
    bf16_t* Qs = (bf16_t*)lds;
    bf16_t* Ks = Qs + 512 * 72;
    bf16_t* Vs = Ks + 64 * 72;
    int b, qb, kvh; bool isctx; int qrow0;
    if (item < 256) { isctx = false; b = item >> 7; qb = (item >> 1) & 63; kvh = item & 1; qrow0 = b * SEQ + qb * 128; }
    else { const int ci = item - 256; isctx = true; b = ci >> 2; qb = (ci >> 1) & 1; kvh = ci & 1; qrow0 = TOKL + b * CTXL + qb * 128; }
    const int lo = isctx ? 0 : (qb * 2 - 2 < 0 ? 0 : qb * 2 - 2), hi = isctx ? -1 : (qb * 2 + 3 > 127 ? 127 : qb * 2 + 3);
    const int nl = hi - lo + 1, ntile = nl + 4;
    const int key = t >> 3, seg = t & 7;
    const size_t vrow = (size_t)((b * 2 + kvh) * 64 + key);
    u32x4 kraw, vraw;
    {
        const bool loc0 = nl > 0; const int kt0 = loc0 ? lo : 0;
        const size_t krow = loc0 ? ((size_t)b * SEQ + kt0 * 64 + key) : ((size_t)TOKL + b * CTXL + kt0 * 64 + key);
        kraw = *(const u32x4*)(P + krow * INWP + 512 + kvh * 64 + seg * 8);
        vraw = *(const u32x4*)(loc0 ? (VTL + vrow * SEQ + kt0 * 64 + seg * 8) : (VTC + vrow * CTXL + kt0 * 64 + seg * 8));
    }
    __syncthreads();
    {
        u32x4 qraw[8];
#pragma unroll
        for (int i = 0; i < 8; ++i) { const int id = i * NT + t, row = id >> 3, g = row >> 7, rr = row & 127; qraw[i] = *(const u32x4*)(P + (size_t)(qrow0 + rr) * INWP + (kvh * 4 + g) * 64 + (id & 7) * 8); }
#pragma unroll
        for (int i = 0; i < 8; ++i) { const int id = i * NT + t, row = id >> 3, rr = row & 127; stage_norm_rope(qraw[i], row, id & 7, qg, !isctx, qb * 128 + rr, ropel, 0.125f * 1.44269504f, Qs); }
    }
    {
        const bool loc0 = nl > 0; const int kt0 = loc0 ? lo : 0;
        stage_norm_rope(kraw, key, seg, kgn, loc0, kt0 * 64 + key, ropel, 1.f, Ks);
        *(u32x4*)(Vs + key * 72 + seg * 8) = vraw;
    }
    __syncthreads();
    const int g = wid >> 1, half = wid & 1;
    const bf16_t* Qw = Qs + (g * 128 + half * 64 + fr) * 72 + fq * 8;
    const float sinkv = p.sink[l * 8 + kvh * 4 + g] * 1.44269504f;
    float mrun[4], lrun[4]; f32x4 o[4][4];
#pragma unroll
    for (int n = 0; n < 4; ++n) { mrun[n] = sinkv; lrun[n] = fq == 0 ? 1.f : 0.f;
#pragma unroll
        for (int dt = 0; dt < 4; ++dt) o[dt][n] = (f32x4){0.f, 0.f, 0.f, 0.f}; }
    for (int ti = 0; ti < ntile; ++ti) {
        const bool local = ti < nl; const int kt = local ? lo + ti : ti - nl;
        const bool more = ti + 1 < ntile;
        const bool nloc = (ti + 1) < nl; const int nkt = nloc ? lo + ti + 1 : ti + 1 - nl;
        if (more) {
            const size_t krow = nloc ? ((size_t)b * SEQ + nkt * 64 + key) : ((size_t)TOKL + b * CTXL + nkt * 64 + key);
            kraw = *(const u32x4*)(P + krow * INWP + 512 + kvh * 64 + seg * 8);
            vraw = *(const u32x4*)(nloc ? (VTL + vrow * SEQ + nkt * 64 + seg * 8) : (VTC + vrow * CTXL + nkt * 64 + seg * 8));
        }
        const bool domask = local && (kt < 2 * qb || kt > 2 * qb + 1);
#pragma unroll 1
        for (int kh = 0; kh < 2; ++kh) {
            f32x4 s[2][4];
#pragma unroll
            for (int m = 0; m < 2; ++m)
#pragma unroll
                for (int n = 0; n < 4; ++n) s[m][n] = (f32x4){0.f, 0.f, 0.f, 0.f};
#pragma unroll
            for (int ks = 0; ks < 2; ++ks) {
                bf16x8 qf[4];
#pragma unroll
                for (int n = 0; n < 4; ++n) qf[n] = *(const bf16x8*)(Qw + n * 16 * 72 + ks * 32);
#pragma unroll
                for (int m = 0; m < 2; ++m) {
                    const bf16x8 kf = *(const bf16x8*)(Ks + ((kh * 2 + m) * 16 + fr) * 72 + ks * 32 + fq * 8);
#pragma unroll
                    for (int n = 0; n < 4; ++n) s[m][n] = mfma16(kf, qf[n], s[m][n]);
                }
            }
            if (domask) {
#pragma unroll
                for (int m = 0; m < 2; ++m)
#pragma unroll
                    for (int n = 0; n < 4; ++n)
#pragma unroll
                        for (int j = 0; j < 4; ++j) {
                            const int kpos = kt * 64 + (kh * 2 + m) * 16 + fq * 4 + j, qpos = qb * 128 + half * 64 + n * 16 + fr;
                            const int df = qpos - kpos;
                            if (df > 128 || df < -128) s[m][n][j] = -1e30f;
                        }
            }
#pragma unroll
            for (int n = 0; n < 4; ++n) {
                float mx = -1e30f;
#pragma unroll
                for (int m = 0; m < 2; ++m)
#pragma unroll
                    for (int j = 0; j < 4; ++j) mx = fmaxf(mx, s[m][n][j]);
                if (__builtin_amdgcn_ballot_w64(mx > mrun[n] + 8.f) != 0ull) {
                    mx = red_max_16_32(mx);
                    const float mnew = fmaxf(mrun[n], mx);
                    const float alpha = __builtin_amdgcn_exp2f(mrun[n] - mnew);
                    lrun[n] *= alpha; mrun[n] = mnew;
#pragma unroll
                    for (int dt = 0; dt < 4; ++dt) o[dt][n] = o[dt][n] * alpha;
                }
                const float mref = mrun[n];
                float rs = 0.f;
#pragma unroll
                for (int m = 0; m < 2; ++m)
#pragma unroll
                    for (int j = 0; j < 4; ++j) { const float pv = __builtin_amdgcn_exp2f(s[m][n][j] - mref); s[m][n][j] = pv; rs += pv; }
                lrun[n] += rs;
            }
            {
                bf16x8 pb[4];
#pragma unroll
                for (int n = 0; n < 4; ++n) {
                    u32x4 u; u.x = pk2(s[0][n][0], s[0][n][1]); u.y = pk2(s[0][n][2], s[0][n][3]); u.z = pk2(s[1][n][0], s[1][n][1]); u.w = pk2(s[1][n][2], s[1][n][3]);
                    pb[n] = __builtin_bit_cast(bf16x8, u);
                }
#pragma unroll
                for (int dt = 0; dt < 4; ++dt) {
                    const bf16x4 v0 = *(const bf16x4*)(Vs + (dt * 16 + fr) * 72 + (2 * kh) * 16 + fq * 4);
                    const bf16x4 v1 = *(const bf16x4*)(Vs + (dt * 16 + fr) * 72 + (2 * kh + 1) * 16 + fq * 4);
                    const bf16x8 va = __builtin_shufflevector(v0, v1, 0, 1, 2, 3, 4, 5, 6, 7);
#pragma unroll
                    for (int n = 0; n < 4; ++n) o[dt][n] = mfma16(va, pb[n], o[dt][n]);
                }
            }
        }
        if (more) {
            __syncthreads();
            stage_norm_rope(kraw, key, seg, kgn, nloc, nkt * 64 + key, ropel, 1.f, Ks);
            *(u32x4*)(Vs + key * 72 + seg * 8) = vraw;
            __syncthreads();
        }
    }
#pragma unroll
    for (int n = 0; n < 4; ++n) {
        const float inv = 1.f / red_sum_16_32(lrun[n]);
        const size_t row = (size_t)qrow0 + half * 64 + n * 16 + fr;
#pragma unroll
        for (int dt = 0; dt < 4; ++dt) {
            const f32x4 v = o[dt][n] * inv;
            u32x2 u; u.x = pk2(v.x, v.y); u.y = pk2(v.z, v.w);
            *(u32x2*)(MIX + row * DM + (kvh * 4 + g) * 64 + dt * 16 + fq * 4) = u;
        }
    }
}

DEVI void f1_load(const Params& p, int item, u32x4& a, u32x4& c2) {
    const int t = tidx(), g = item & 3, n2 = (item >> 2) & 63, b = item >> 8, n1 = t >> 2, cs = (t & 3) * 16;
    const bf16_t* src = (const bf16_t*)(p.ws + WS_P) + (size_t)(b * SEQ + 64 * n1 + n2) * INWP + 768 + g * 64 + cs;
    a = *(const u32x4*)src; c2 = *(const u32x4*)(src + 8);
}
DEVI void f1_item(const Params& p, int item, unsigned char* lds, u32x4& a, u32x4& c2, int next) {
    const int t = tidx(), lane = t & 63, w = t >> 6, fr = lane & 15, fq = lane >> 4;
    const int g = item & 3, n2 = (item >> 2) & 63, b = item >> 8;
    const bf16_t* D128 = (const bf16_t*)(p.ws + WS_D128);
    bf16_t* YP = (bf16_t*)(p.ws + WS_YP);
    bf16_t* uT = (bf16_t*)lds;
    __syncthreads();
    {
        const int n1 = t >> 2, cs = (t & 3) * 16;
        const unsigned uu[8] = {a.x, a.y, a.z, a.w, c2.x, c2.y, c2.z, c2.w};
        if (next >= 0) f1_load(p, next, a, c2);
#pragma unroll
        for (int i = 0; i < 8; ++i) { uT[(cs + 2 * i) * 136 + n1] = (bf16_t)(uu[i] & 0xffffu); uT[(cs + 2 * i + 1) * 136 + n1] = (bf16_t)(uu[i] >> 16); }
    }
    __syncthreads();
    f32x4 ar[4], ai[4];
#pragma unroll
    for (int n = 0; n < 4; ++n) { ar[n] = (f32x4){0.f, 0.f, 0.f, 0.f}; ai[n] = (f32x4){0.f, 0.f, 0.f, 0.f}; }
#pragma unroll
    for (int ks = 0; ks < 4; ++ks) {
        const bf16x8 a0 = *(const bf16x8*)(D128 + ((2 * w) * 16 + fr) * 128 + ks * 32 + fq * 8);
        const bf16x8 a1 = *(const bf16x8*)(D128 + ((2 * w + 1) * 16 + fr) * 128 + ks * 32 + fq * 8);
#pragma unroll
        for (int n = 0; n < 4; ++n) {
            const bf16x8 bb = *(const bf16x8*)(uT + (n * 16 + fr) * 136 + ks * 32 + fq * 8);
            ar[n] = mfma16(a0, bb, ar[n]); ai[n] = mfma16(a1, bb, ai[n]);
        }
    }
#pragma unroll
    for (int j = 0; j < 4; ++j) {
        const int k1 = 16 * w + fq * 4 + j;
        const float a = (float)(n2 * k1) * (1.f / 8192.f);
        const float tc = __builtin_amdgcn_cosf(a), ts = __builtin_amdgcn_sinf(a);
#pragma unroll
        for (int n = 0; n < 4; ++n) {
            const int c = n * 16 + fr;
            const float yr = ar[n][j], yi = ai[n][j];
            const float pr = yr * tc + yi * ts, pi = yi * tc - yr * ts;
            const size_t base = ((size_t)((b * 4 + g) * 128 + k1) * 2) * 4096 + n2 * 64 + c;
            YP[base] = f2bf(pr); YP[base + 4096] = f2bf(pi);
        }
    }
}

DEVI void f2_load(const Params& p, int item, bool cx, u32x4& a, u32x4& c2) {
    const int t = tidx(), rowi = t >> 2, cs = (t & 3) * 16;
    const int k1 = cx ? (item & 3) : (item & 127), g = cx ? ((item >> 2) & 3) : ((item >> 7) & 3), b = cx ? (item >> 4) : (item >> 9);
    const bf16_t* src = (const bf16_t*)(p.ws + (cx ? WS_YPC : WS_YP)) + ((size_t)((b * 4 + g) * (cx ? 4 : 128) + k1) * 128 + rowi) * 64 + cs;
    a = *(const u32x4*)src; c2 = *(const u32x4*)(src + 8);
}
DEVI void f2_item(const Params& p, int l, int item, unsigned char* lds, const bool cx, u32x4& a, u32x4& c2, int next, bool nextcx) {
    const int t = tidx(), lane = t & 63, w = t >> 6, fr = lane & 15, fq = lane >> 4;
    const int k1 = cx ? (item & 3) : (item & 127), g = cx ? ((item >> 2) & 3) : ((item >> 7) & 3), b = cx ? (item >> 4) : (item >> 9);
    const bf16_t* T64 = (const bf16_t*)(p.ws + WS_T64);
    const bf16_t* MMT = (const bf16_t*)(p.ws + WS_MMT) + (size_t)(l * 4 + g) * 8192;
    bf16_t* MIX = (bf16_t*)(p.ws + WS_MIX);
    bf16_t* Bt = (bf16_t*)lds;
    bf16_t* XX = Bt + 64 * 136;
    __syncthreads();
    {
        const int rowi = t >> 2, cs = (t & 3) * 16;
        const unsigned uu[8] = {a.x, a.y, a.z, a.w, c2.x, c2.y, c2.z, c2.w};
        if (next >= 0) f2_load(p, next, nextcx, a, c2);
#pragma unroll
        for (int i = 0; i < 8; ++i) { Bt[(cs + 2 * i) * 136 + rowi] = (bf16_t)(uu[i] & 0xffffu); Bt[(cs + 2 * i + 1) * 136 + rowi] = (bf16_t)(uu[i] >> 16); }
    }
    __syncthreads();
    f32x4 acc[4];
#pragma unroll
    for (int n = 0; n < 4; ++n) acc[n] = (f32x4){0.f, 0.f, 0.f, 0.f};
#pragma unroll
    for (int ks = 0; ks < 4; ++ks) {
        const bf16x8 a = *(const bf16x8*)(T64 + (w * 16 + fr) * 128 + ks * 32 + fq * 8);
#pragma unroll
        for (int n = 0; n < 4; ++n) acc[n] = mfma16(a, *(const bf16x8*)(Bt + (n * 16 + fr) * 136 + ks * 32 + fq * 8), acc[n]);
    }
    {
        const int po = w & 1;
#pragma unroll
        for (int n = 0; n < 4; ++n)
#pragma unroll
            for (int j = 0; j < 4; ++j) { const int k2 = (w >> 1) * 16 + fq * 4 + j; XX[k2 * 136 + po * 64 + n * 16 + fr] = f2bf(acc[n][j]); }
    }
    __syncthreads();
    const int kt2 = w >> 1;
    f32x4 a2[2];
    a2[0] = (f32x4){0.f, 0.f, 0.f, 0.f}; a2[1] = (f32x4){0.f, 0.f, 0.f, 0.f};
#pragma unroll
    for (int ks = 0; ks < 4; ++ks) {
        const bf16x8 bx = *(const bf16x8*)(XX + (kt2 * 16 + fr) * 136 + ks * 32 + fq * 8);
#pragma unroll
        for (int ei = 0; ei < 2; ++ei) { const int et = (w & 1) * 2 + ei; a2[ei] = mfma16(*(const bf16x8*)(MMT + (et * 16 + fr) * 128 + ks * 32 + fq * 8), bx, a2[ei]); }
    }
#pragma unroll
    for (int ei = 0; ei < 2; ++ei) {
        const int et = (w & 1) * 2 + ei, k2 = kt2 * 16 + fr, e = et * 16 + fq * 4;
        const float sc = cx ? 5.656854249f : 1.f;
        u32x2 u; u.x = pk2(a2[ei].x * sc, a2[ei].y * sc); u.y = pk2(a2[ei].z * sc, a2[ei].w * sc);
        const size_t orow = cx ? (size_t)(TOKL + b * CTXL + k1 + 4 * k2) : (size_t)(b * SEQ + k1 + 128 * k2);
        *(u32x2*)(MIX + orow * DM + 512 + g * 64 + e) = u;
    }
}

DEVI void cf_item(const Params& p, int l, int item, unsigned char* lds) {
    const int t = tidx();
    const int g = item & 3, b = item >> 2;
    const bf16_t* P = (const bf16_t*)(p.ws + WS_P);
    bf16_t* YPC = (bf16_t*)(p.ws + WS_YPC);
    const int n2 = t >> 3, cg8 = (t & 7) * 8;
    float u[4][8];
#pragma unroll
    for (int n1 = 0; n1 < 4; ++n1) unpack8(*(const u32x4*)(P + (size_t)(TOKL + b * CTXL + 64 * n1 + n2) * INWP + 768 + g * 64 + cg8), u[n1]);
#pragma unroll
    for (int k1 = 0; k1 < 4; ++k1) {
        const float a = (float)(n2 * k1) * (1.f / 256.f); const float tc = __builtin_amdgcn_cosf(a), ts = __builtin_amdgcn_sinf(a);
        float pr[8], pi[8];
#pragma unroll
        for (int i = 0; i < 8; ++i) {
            float yr, yi;
            if (k1 == 0) { yr = (u[0][i] + u[2][i]) + (u[1][i] + u[3][i]); yi = 0.f; }
            else if (k1 == 1) { yr = u[0][i] - u[2][i]; yi = u[3][i] - u[1][i]; }
            else if (k1 == 2) { yr = (u[0][i] + u[2][i]) - (u[1][i] + u[3][i]); yi = 0.f; }
            else { yr = u[0][i] - u[2][i]; yi = u[1][i] - u[3][i]; }
            pr[i] = yr * tc + yi * ts; pi[i] = yi * tc - yr * ts;
        }
        bf16_t* dst = YPC + ((size_t)(((b * 4 + g) * 4 + k1) * 2)) * 4096 + n2 * 64 + cg8;
        *(u32x4*)dst = pack8(pr); *(u32x4*)(dst + 4096) = pack8(pi);
    }
}

DEVI void gla_gates16(const Params& p, int l, int row0, int h, float* gzs, float (&v)[16]) {
    const int t = tidx();
    const bf16_t* P = (const bf16_t*)(p.ws + WS_P);
    float w[16]; float bias;
    {
        const int d = t & 63, dir = (t >> 6) & 1;
        const float* wg = (dir ? p.wgb : p.wgf) + (size_t)l * 16 * 256 + h * 64 + d;
        bias = (dir ? p.bgb : p.bgf)[l * 256 + h * 64 + d];
#pragma unroll
        for (int r = 0; r < 16; ++r) w[r] = wg[r * 256];
    }
    {
        const int tok = t >> 3, sg = (t & 7) * 4;
        const u32x2 u = *(const u32x2*)(P + (size_t)(row0 + tok) * INWP + 2048 + sg);
        gzs[tok * 32 + sg + 0] = bflo(u.x); gzs[tok * 32 + sg + 1] = bfhi(u.x); gzs[tok * 32 + sg + 2] = bflo(u.y); gzs[tok * 32 + sg + 3] = bfhi(u.y);
    }
    __syncthreads();
    {
        const int dir = (t >> 6) & 1, tq = t >> 7;
#pragma unroll
        for (int i = 0; i < 16; ++i) {
            const int tok = tq * 16 + i;
            typedef float f32x2_t __attribute__((ext_vector_type(2)));
            f32x2_t z2 = {bias, 0.f};
#pragma unroll
            for (int r = 0; r < 16; r += 2) z2 += (f32x2_t){gzs[tok * 32 + dir * 16 + r], gzs[tok * 32 + dir * 16 + r + 1]} * (f32x2_t){w[r], w[r + 1]};
            const float z = z2.x + z2.y;
            const float ls = fminf(z, 0.f) - __logf(1.f + __expf(-fabsf(z)));
            v[i] = ls * (1.f / 16.f);
        }
    }
    __syncthreads();
}
DEVI void gla_scan16(float (&v)[16], float* la, float* gzs) {
    const int t = tidx();
    const int d = t & 63, dir = (t >> 6) & 1, q = t >> 7;
    float* col = la + (dir * 64) * 64 + d;
    if (dir == 0) {
#pragma unroll
        for (int i = 1; i < 16; ++i) v[i] += v[i - 1];
        gzs[(q * 2 + dir) * 64 + d] = v[15];
    } else {
#pragma unroll
        for (int i = 14; i >= 0; --i) v[i] += v[i + 1];
        gzs[(q * 2 + dir) * 64 + d] = v[0];
    }
    __syncthreads();
    float off = 0.f;
#pragma unroll
    for (int qq = 0; qq < 4; ++qq) { const float tv = gzs[(qq * 2 + dir) * 64 + d]; if (dir == 0 ? (qq < q) : (qq > q)) off += tv; }
#pragma unroll
    for (int i = 0; i < 16; ++i) col[(q * 16 + i) * 64] = v[i] + off;
    __syncthreads();
}
DEVI int gla_row0(int b, int mc) { return mc < 4 ? (TOKL + b * CTXL + mc * 64) : (b * SEQ + (mc - 4) * 64); }
DEVI int gla_ci(int dir, int mc) { return dir == 0 ? mc : (mc < 4 ? 3 - mc : 135 - mc); }

DEVI void g1_item(const Params& p, int l, int item, unsigned char* lds) {
    const int t = tidx(), lane = t & 63, w = t >> 6, fr = lane & 15, fq = lane >> 4;
    const int h = item & 3, mc = (item >> 2) % NCI, b = (item >> 2) / NCI;
    const int row0 = gla_row0(b, mc);
    const bf16_t* P = (const bf16_t*)(p.ws + WS_P);
    bf16_t* UT = (bf16_t*)(p.ws + WS_UT);
    float* DEC = (float*)(p.ws + WS_DEC);
    float* la = (float*)lds;
    bf16_t* kT = (bf16_t*)(lds + 32768);
    bf16_t* vT = kT + 2 * 64 * 72;
    float* gzs = (float*)(lds + 32768 + 3 * 64 * 72 * 2);
    const u32x4 kraw = *(const u32x4*)(P + (size_t)(row0 + (t >> 3)) * INWP + 1280 + h * 64 + (t & 7) * 8);
    const u32x4 vraw = *(const u32x4*)(P + (size_t)(row0 + (t >> 3)) * INWP + 1536 + h * 64 + (t & 7) * 8);
    __syncthreads();
    {
        float lv[16];
        gla_gates16(p, l, row0, h, gzs, lv);
        bf16_t* LA = (bf16_t*)(p.ws + WS_LA) + (size_t)item * 8192 + (((t >> 6) & 1) * 64 + (t >> 7) * 16) * 64 + (t & 63);
#pragma unroll
        for (int i2 = 0; i2 < 16; ++i2) LA[i2 * 64] = f2bf(lv[i2]);
        gla_scan16(lv, la, gzs);
    }
    {
        const int s = t >> 3, seg = (t & 7) * 8;
        float kv[8], vv[8];
        unpack8(kraw, kv);
        unpack8(vraw, vv);
#pragma unroll
        for (int i = 0; i < 8; ++i) {
            const int d = seg + i;
            const float bt0 = la[63 * 64 + d], bt1 = la[64 * 64 + d];
            kT[(d) * 72 + s] = f2bf(kv[i] * __expf(bt0 - la[s * 64 + d]));
            kT[(64 + d) * 72 + s] = f2bf(kv[i] * __expf(bt1 - la[(64 + s) * 64 + d]));
            vT[d * 72 + s] = raw16(vraw, i);
        }
        if (t < 128) { const int dir = t >> 6, d = t & 63; const float bt = dir ? la[64 * 64 + d] : la[63 * 64 + d];
            DEC[((size_t)((b * 2 + dir) * NCI + gla_ci(dir, mc)) * 4 + h) * 64 + d] = __expf(bt); }
    }
    __syncthreads();
    {
        const int dir = w >> 2, mt = w & 3;
        f32x4 acc[4];
#pragma unroll
        for (int n = 0; n < 4; ++n) acc[n] = (f32x4){0.f, 0.f, 0.f, 0.f};
#pragma unroll
        for (int ks = 0; ks < 2; ++ks) {
            const bf16x8 a = *(const bf16x8*)(kT + (dir * 64 + mt * 16 + fr) * 72 + ks * 32 + fq * 8);
#pragma unroll
            for (int n = 0; n < 4; ++n) acc[n] = mfma16(a, *(const bf16x8*)(vT + (n * 16 + fr) * 72 + ks * 32 + fq * 8), acc[n]);
        }
        bf16_t* dst = UT + ((size_t)((b * 2 + dir) * NCI + gla_ci(dir, mc)) * 4 + h) * 4096;
#pragma unroll
        for (int n = 0; n < 4; ++n) { u32x2 u; u.x = pk2(acc[n].x, acc[n].y); u.y = pk2(acc[n].z, acc[n].w); *(u32x2*)(dst + (n * 16 + fr) * 64 + mt * 16 + fq * 4) = u; }
    }
}

DEVI void g2_item(const Params& p, int item) {
    const int gid = item * NT + tidx();
    const int d = gid & 63, e = (gid >> 6) & 63, h = (gid >> 12) & 3, bd = gid >> 14;
    bf16_t* u = (bf16_t*)(p.ws + WS_UT) + ((size_t)bd * NCI * 4 + h) * 4096 + e * 64 + d;
    const float* dc = (const float*)(p.ws + WS_DEC) + ((size_t)bd * NCI * 4 + h) * 64 + d;
    float s = 0.f;
    for (int c0 = 0; c0 < NCI; c0 += 33) {
        float uv[33], dv[33];
#pragma unroll
        for (int i = 0; i < 33; ++i) { uv[i] = bf2f(u[(size_t)(c0 + i) * 4 * 4096]); dv[i] = dc[(size_t)(c0 + i) * 256]; }
#pragma unroll
        for (int i = 0; i < 33; ++i) { u[(size_t)(c0 + i) * 4 * 4096] = f2bf(s); s = dv[i] * s + uv[i]; }
    }
}

struct G3Pre { u32x4 q, k, v, r; bf16_t la[16]; };
DEVI void g3_load(const Params& p, int item, G3Pre& d) {
    const int t = tidx();
    const int h = item & 3, mc = (item >> 2) % NCI, b = (item >> 2) / NCI;
    const int row0 = mc < 4 ? (TOKL + b * CTXL + mc * 64) : (b * SEQ + (mc - 4) * 64);
    const bf16_t* prow = (const bf16_t*)(p.ws + WS_P) + (size_t)(row0 + (t >> 3)) * INWP + h * 64 + (t & 7) * 8;
    d.q = *(const u32x4*)(prow + 1024); d.k = *(const u32x4*)(prow + 1280); d.v = *(const u32x4*)(prow + 1536); d.r = *(const u32x4*)(prow + 1792);
    const bf16_t* LA = (const bf16_t*)(p.ws + WS_LA) + (size_t)item * 8192 + (((t >> 6) & 1) * 64 + (t >> 7) * 16) * 64 + (t & 63);
#pragma unroll
    for (int i2 = 0; i2 < 16; ++i2) d.la[i2] = LA[i2 * 64];
}
DEVI void g3_item(const Params& p, int l, int item, unsigned char* lds, G3Pre& pre, int next) {
    const int t = tidx(), lane = t & 63, w = t >> 6, fr = lane & 15, fq = lane >> 4;
    const int h = item & 3, mc = (item >> 2) % NCI, b = (item >> 2) / NCI;
    const int row0 = gla_row0(b, mc);
    const bf16_t* P = (const bf16_t*)(p.ws + WS_P);
    const bf16_t* ST = (const bf16_t*)(p.ws + WS_UT);
    bf16_t* MIX = (bf16_t*)(p.ws + WS_MIX);
    float* la = (float*)lds;
    bf16_t* qi = (bf16_t*)(lds + 32768);
    bf16_t* ki = (bf16_t*)(lds + 51200);
    bf16_t* vT = (bf16_t*)(lds + 69632);
    bf16_t* sT = (bf16_t*)(lds + 78848);
    float* gzs = (float*)(lds + 97280);
    float* O = (float*)(lds + 105472);
    const u32x4 qraw = pre.q, kraw = pre.k, vraw = pre.v, rraw = pre.r;
    float lv[16];
#pragma unroll
    for (int i2 = 0; i2 < 16; ++i2) lv[i2] = bf2f(pre.la[i2]);
    if (next >= 0) g3_load(p, next, pre);
    __syncthreads();
    gla_scan16(lv, la, gzs);
    {
        const int s = t >> 3, seg = (t & 7) * 8;
        float qv[8], kv[8], vv[8];
        unpack8(qraw, qv);
        unpack8(kraw, kv);
        unpack8(vraw, vv);
#pragma unroll
        for (int dir = 0; dir < 2; ++dir) {
            float a[8], c[8];
#pragma unroll
            for (int i = 0; i < 8; ++i) { const float bc = la[(dir * 64 + s) * 64 + seg + i]; a[i] = qv[i] * 0.125f * __expf(bc); c[i] = kv[i] * __expf(-bc); }
            *(u32x4*)(qi + (dir * 64 + s) * 72 + seg) = pack8(a);
            *(u32x4*)(ki + (dir * 64 + s) * 72 + seg) = pack8(c);
        }
#pragma unroll
        for (int i = 0; i < 8; ++i) vT[(seg + i) * 72 + s] = raw16(vraw, i);
#pragma unroll
        for (int i = 0; i < 2; ++i) {
            const int id = i * NT + t, dir = id >> 9, e = (id >> 3) & 63, sg = (id & 7) * 8;
            const bf16_t* src = ST + ((size_t)((b * 2 + dir) * NCI + gla_ci(dir, mc)) * 4 + h) * 4096 + e * 64 + sg;
            *(u32x4*)(sT + (dir * 64 + e) * 72 + sg) = *(const u32x4*)src;
        }
    }
    __syncthreads();
    {
        const int dir = w >> 2, nt = w & 3;
        bf16x8 bq[2];
#pragma unroll
        for (int ks = 0; ks < 2; ++ks) bq[ks] = *(const bf16x8*)(qi + (dir * 64 + nt * 16 + fr) * 72 + ks * 32 + fq * 8);
        f32x4 sa[4];
#pragma unroll
        for (int m = 0; m < 4; ++m) sa[m] = (f32x4){0.f, 0.f, 0.f, 0.f};
#pragma unroll
        for (int ks = 0; ks < 2; ++ks)
#pragma unroll
            for (int m = 0; m < 4; ++m) sa[m] = mfma16(*(const bf16x8*)(ki + (dir * 64 + m * 16 + fr) * 72 + ks * 32 + fq * 8), bq[ks], sa[m]);
        const int tt = nt * 16 + fr;
#pragma unroll
        for (int m = 0; m < 4; ++m)
#pragma unroll
            for (int j = 0; j < 4; ++j) { const int s = m * 16 + fq * 4 + j; const bool keep = dir ? (s >= tt) : (s <= tt); if (!keep) sa[m][j] = 0.f; }
        f32x4 oa[4];
#pragma unroll
        for (int et = 0; et < 4; ++et) oa[et] = (f32x4){0.f, 0.f, 0.f, 0.f};
#pragma unroll
        for (int k2 = 0; k2 < 2; ++k2) {
            u32x4 u; u.x = pk2(sa[2 * k2][0], sa[2 * k2][1]); u.y = pk2(sa[2 * k2][2], sa[2 * k2][3]); u.z = pk2(sa[2 * k2 + 1][0], sa[2 * k2 + 1][1]); u.w = pk2(sa[2 * k2 + 1][2], sa[2 * k2 + 1][3]);
            const bf16x8 pb = __builtin_bit_cast(bf16x8, u);
#pragma unroll
            for (int et = 0; et < 4; ++et) {
                const bf16x4 v0 = *(const bf16x4*)(vT + (et * 16 + fr) * 72 + (2 * k2) * 16 + fq * 4);
                const bf16x4 v1 = *(const bf16x4*)(vT + (et * 16 + fr) * 72 + (2 * k2 + 1) * 16 + fq * 4);
                oa[et] = mfma16(__builtin_shufflevector(v0, v1, 0, 1, 2, 3, 4, 5, 6, 7), pb, oa[et]);
            }
        }
#pragma unroll
        for (int ks = 0; ks < 2; ++ks)
#pragma unroll
            for (int et = 0; et < 4; ++et) oa[et] = mfma16(*(const bf16x8*)(sT + (dir * 64 + et * 16 + fr) * 72 + ks * 32 + fq * 8), bq[ks], oa[et]);
#pragma unroll
        for (int et = 0; et < 4; ++et)
            *(f32x4*)(O + (dir * 64 + tt) * 68 + et * 16 + fq * 4) = oa[et];
    }
    __syncthreads();
    {
        const int tok = t >> 3, seg = (t & 7) * 8;
        float ov[8], rv[8]; float ss = 0.f;
        { const f32x4 a0 = *(const f32x4*)(O + tok * 68 + seg), a1 = *(const f32x4*)(O + tok * 68 + seg + 4), b0 = *(const f32x4*)(O + (64 + tok) * 68 + seg), b1 = *(const f32x4*)(O + (64 + tok) * 68 + seg + 4);
          const f32x4 s0 = a0 + b0, s1 = a1 + b1; ov[0] = s0.x; ov[1] = s0.y; ov[2] = s0.z; ov[3] = s0.w; ov[4] = s1.x; ov[5] = s1.y; ov[6] = s1.z; ov[7] = s1.w; }
#pragma unroll
        for (int i = 0; i < 8; ++i) ss += ov[i] * ov[i];
        ss += dpp_xor1(ss); ss += dpp_xor2(ss); ss += __shfl_xor(ss, 4);
        const float rstd = rsqrtf(ss * (1.f / 64.f) + 1e-6f);
        unpack8(rraw, rv);
#pragma unroll
        for (int i = 0; i < 8; ++i) ov[i] = ov[i] * rstd * p.glag[l * 64 + seg + i] * silu_f(rv[i]);
        *(u32x4*)(MIX + (size_t)(row0 + tok) * DM + 768 + h * 64 + seg) = pack8(ov);
    }
}

constexpr int NPH = 19;
DEVI void run_phase(const Params& p, int ph, unsigned char* lds) {
    if (ph == 0) { prep_phase(p, lds); return; }
    const int l = (ph - 1) / 9, s = (ph - 1) % 9;
    const bool last = (l == 1);
    const float* MOD = (const float*)(p.ws + WS_MOD) + l * 3 * 6144;
    bf16_t* H = (bf16_t*)(p.ws + WS_H);
    float* XC = (float*)(p.ws + WS_XC);
    switch (s) {
    case 0: norm_phase(p, l, 0); break;
    case 1: { EpiInProj e{(bf16_t*)(p.ws + WS_P), (bf16_t*)(p.ws + WS_VTL), (bf16_t*)(p.ws + WS_VTC)};
              gemm_phase8(H, (const bf16_t*)(p.ws + WS_WIN + l * SZ_WIN), DM, 66, 9, e, lds);
              {
                  const int G = gridDim.x, rem = (66 * 9) % G, first = rem ? rem : 0, nidle = G - first;
                  if ((int)blockIdx.x >= first) prep_phase(p, lds, l == 0 ? 1 : 2, first, nidle);
              } } break;
    case 2: {
        const int nA = last ? 256 : 264, nCF = last ? 0 : 8, nF1 = 512, nG1 = 2 * NCI * 4;
        const int G = gridDim.x;
        { const float* rt = (const float*)(p.ws + WS_ROPE); float* rl = (float*)(lds + ROPE_LDS_OFF); for (int i = tidx(); i < 4096; i += NT) rl[i] = rt[i]; }
        for (int it = blockIdx.x; it < nA; it += G) attn_item(p, l, it, lds);
        for (int it = (blockIdx.x + G - (nA % G)) % G; it < nCF; it += G) cf_item(p, l, it, lds);
        int g1s, g1n, gstep = 1, f1a = 0, f1n = 0, f1x = -1, fstep = 1;
        const int bx = blockIdx.x;
        if (G == 256) {
            if (!last) {
                if (bx < 8) { g1s = 3 * bx; g1n = 3; f1a = bx; f1n = 1; }
                else if (bx < 16) { g1s = 24 + 4 * (bx - 8); g1n = 4; f1a = bx; f1n = 1; }
                else if (bx < 56) { g1s = 56 + 5 * (bx - 16); g1n = 5; }
                else { g1s = 256 + 4 * (bx - 56); g1n = 4; f1a = 16 + 2 * (bx - 56); f1n = 2; if (bx < 152) f1x = 416 + (bx - 56); }
            } else {
                if (bx < 32) { g1s = 5 * bx; g1n = 5; }
                else { g1s = 160 + 4 * (bx - 32); g1n = 4; f1a = 2 * (bx - 32); f1n = 2; if (bx < 96) f1x = 448 + (bx - 32); }
            }
        } else {
            f1a = (bx + G - ((nA + nCF) % G)) % G; fstep = G; f1n = f1a < nF1 ? (nF1 - 1 - f1a) / G + 1 : 0;
            g1s = (bx + G - ((nA + nCF + nF1) % G)) % G; gstep = G; g1n = g1s < nG1 ? (nG1 - 1 - g1s) / G + 1 : 0;
        }
        {
            const int ftot = f1n + (f1x >= 0 ? 1 : 0);
            u32x4 fa, fc;
            if (ftot > 0) f1_load(p, f1a, fa, fc);
            for (int j = 0; j < ftot; ++j) {
                const int cur = j < f1n ? f1a + j * fstep : f1x;
                const int nxt = j + 1 < f1n ? f1a + (j + 1) * fstep : (j + 1 < ftot ? f1x : -1);
                f1_item(p, cur, lds, fa, fc, nxt);
            }
        }
        for (int j = 0; j < g1n; ++j) g1_item(p, l, g1s + j * gstep, lds);
    } break;
    case 3: {
        const int nG2 = 128, nF2 = 1024, nF2c = last ? 0 : 32;
        const int G = gridDim.x;
        for (int it = blockIdx.x; it < nG2; it += G) g2_item(p, it);
        if (G == 256) {
            const int bx = blockIdx.x;
            const int first = bx * 4, cnt = 4;
            const bool hasc = bx >= 128 && (bx - 128) < nF2c;
            u32x4 fa, fc; f2_load(p, first, false, fa, fc);
            for (int j = 0; j < cnt; ++j) { const bool lastj = j + 1 == cnt; f2_item(p, l, first + j, lds, false, fa, fc, lastj ? (hasc ? bx - 128 : -1) : first + j + 1, lastj && hasc); }
            if (hasc) f2_item(p, l, bx - 128, lds, true, fa, fc, -1, false);
        } else {
            u32x4 fa, fc;
            for (int it = blockIdx.x; it < nF2; it += G) { f2_load(p, it, false, fa, fc); f2_item(p, l, it, lds, false, fa, fc, -1, false); }
            for (int it = blockIdx.x; it < nF2c; it += G) { f2_load(p, it, true, fa, fc); f2_item(p, l, it, lds, true, fa, fc, -1, false); }
        }
    } break;
    case 4: {
        const int nG3 = 2 * NCI * 4;
        {
            const int G = gridDim.x;
            auto nxt = [&](int it) { for (it += G; it < nG3; it += G) { if (!(last && ((it >> 2) % NCI) < 4)) return it; } return -1; };
            int it = (int)blockIdx.x - G; it = nxt(it);
            G3Pre pre;
            if (it >= 0) g3_load(p, it, pre);
            while (it >= 0) { const int nx = nxt(it); g3_item(p, l, it, lds, pre, nx); it = nx; }
        }
    } break;
    case 5: { EpiResid e{l == 0 ? p.x : p.out, l == 0 ? p.ctx : XC, p.out, XC, MOD, 2 * DM, (float*)(p.ws + WS_PART)};
              gemm_phase8((const bf16_t*)(p.ws + WS_MIX), (const bf16_t*)(p.ws + WS_WOUT + l * SZ_WOUT), DM, 64, 4, e, lds, last ? 0 : 4); } break;
    case 6: norm_phase(p, l, 1); break;
    case 7: { EpiSwiglu e{(bf16_t*)(p.ws + WS_HID)};
              gemm_phase8(H, (const bf16_t*)(p.ws + WS_WFI + l * SZ_WFI), DM, last ? 64 : 66, 22, e, lds); } break;
    case 8: { EpiResid e{p.out, XC, p.out, XC, MOD, 5 * DM, (float*)(p.ws + WS_PART)};
              gemm_phase8((const bf16_t*)(p.ws + WS_HID), (const bf16_t*)(p.ws + WS_WFO + l * SZ_WFO), FFH, 64, 4, e, lds, last ? 0 : 4); } break;
    }
}


#define XB_TMO      128
#define XB_XCNT(j)  (256  + 64 * (j))
#define XB_XSUB(j)  (1280 + 64 * (j))
#define XB_XGEN(j)  (2304 + 64 * (j))
#define XB_TOP      3328
#define XB_TOPGEN   3392
#define XCD_BAR_WORDS 3456
#define XB_SPIN_CAP (1u << 18)
DEVI unsigned xb_ld(unsigned* p) { return __hip_atomic_load(p, __ATOMIC_RELAXED, __HIP_MEMORY_SCOPE_AGENT); }
DEVI unsigned xb_add(unsigned* p, unsigned v) { return __hip_atomic_fetch_add(p, v, __ATOMIC_RELAXED, __HIP_MEMORY_SCOPE_AGENT); }
DEVI unsigned xb_xcc_id() { return (unsigned)__builtin_amdgcn_s_getreg((3 << 11) | 20) & 0xFu; }
#define XB_SPIN(cond, bar) do { unsigned _sp = 0; while (cond) { __builtin_amdgcn_s_sleep(1); \
    if ((++_sp & 255u) == 0u) { if (xb_ld(&(bar)[XB_TMO])) break; if (_sp > XB_SPIN_CAP) { atomicAdd(&(bar)[XB_TMO], 1u); break; } } } } while (0)
struct XcdBarrier { unsigned* bar; unsigned x; volatile __attribute__((address_space(3))) unsigned* st; };
DEVI XcdBarrier xcd_barrier_post(unsigned* bar, volatile __attribute__((address_space(3))) unsigned* st) {
    XcdBarrier b; b.bar = bar; b.x = xb_xcc_id(); b.st = st;
    if (threadIdx.x == 0) (void)xb_add(&bar[XB_XCNT(b.x)], 1u);
    return b;
}
DEVI void xcd_barrier_complete(unsigned* bar, unsigned x, unsigned& nloc, unsigned& nx) {
    const unsigned G = gridDim.x * gridDim.y * gridDim.z;
    unsigned sum, cnt, mine, sp = 0u;
    for (;;) {
        sum = 0u; cnt = 0u; mine = 0u;
#pragma unroll
        for (unsigned j = 0; j < 16; ++j) { const unsigned c = xb_ld(&bar[XB_XCNT(j)]); sum += c; cnt += (c > 0u) ? 1u : 0u; mine = (j == x) ? c : mine; }
        if (sum == G) break;
        __builtin_amdgcn_s_sleep(1);
        if ((++sp & 255u) == 0u) { if (xb_ld(&bar[XB_TMO])) break; if (sp > XB_SPIN_CAP) { atomicAdd(&bar[XB_TMO], 1u); break; } }
    }
    nloc = mine > 0u ? mine : 1u; nx = cnt > 0u ? cnt : 1u;
}
DEVI void xcd_barrier(const XcdBarrier& b) {
    asm volatile("s_waitcnt vmcnt(0)" ::: "memory");
    __syncthreads();
    if (threadIdx.x == 0) {
        unsigned* bar = b.bar;
        __builtin_amdgcn_s_waitcnt(0);
        unsigned nloc = b.st[0], nx = b.st[1];
        if (nloc == 0u) { xcd_barrier_complete(bar, b.x, nloc, nx); b.st[0] = nloc; b.st[1] = nx; }
        const unsigned old = xb_add(&bar[XB_XSUB(b.x)], 1u);
        const unsigned gen = old / nloc;
        if (old + 1u == (gen + 1u) * nloc) {
            __builtin_amdgcn_fence(__ATOMIC_RELEASE, "agent");
            asm volatile("s_waitcnt vmcnt(0)" ::: "memory");
            const unsigned og = xb_add(&bar[XB_TOP], 1u);
            const unsigned tg = og / nx;
            if (og + 1u == (tg + 1u) * nx) xb_add(&bar[XB_TOPGEN], 1u);
            else XB_SPIN(xb_ld(&bar[XB_TOPGEN]) == tg, bar);
            __builtin_amdgcn_fence(__ATOMIC_ACQUIRE, "agent");
            xb_add(&bar[XB_XGEN(b.x)], 1u);
            asm volatile("s_waitcnt vmcnt(0)" ::: "memory");
        } else {
            XB_SPIN(xb_ld(&bar[XB_XGEN(b.x)]) == gen, bar);
            __builtin_amdgcn_fence(__ATOMIC_ACQUIRE, "agent");
            asm volatile("s_waitcnt vmcnt(0)" ::: "memory");
        }
    }
    __syncthreads();
}

__global__ void __launch_bounds__(NT) mega_fwd(Params p) {
    extern __shared__ __attribute__((aligned(16))) unsigned char lds[];
    cg::grid_group grid = cg::this_grid();
    typedef const __attribute__((address_space(4))) Params* kparams_t;
    volatile __attribute__((address_space(3))) unsigned* xst = (volatile __attribute__((address_space(3))) unsigned*)((__attribute__((address_space(3))) unsigned char*)lds + (LDS_BYTES - 16));
    if (threadIdx.x == 0) { xst[0] = 0u; xst[1] = 0u; }
    __syncthreads();
    const bool fused = (p.ph_hi - p.ph_lo) > 1;
    XcdBarrier xb; xb.bar = (unsigned*)(p.ws + WS_BAR); xb.x = 0; xb.st = xst;
    if (fused) xb = xcd_barrier_post((unsigned*)(p.ws + WS_BAR), xst);
    for (int ph = p.ph_lo; ph < p.ph_hi; ++ph) {
        if (ph > p.ph_lo) { if (p.ph_lo < 0) grid.sync(); else xcd_barrier(xb); }
#if defined(__HIP_DEVICE_COMPILE__)
        kparams_t kp = (kparams_t)__builtin_amdgcn_kernarg_segment_ptr();
        asm volatile("" : "+s"(kp));
        Params lp;
        { const __attribute__((address_space(4))) unsigned long long* s8 = (const __attribute__((address_space(4))) unsigned long long*)kp; unsigned long long* d8 = (unsigned long long*)&lp;
#pragma unroll
          for (int i = 0; i < (int)(sizeof(Params) / 8); ++i) d8[i] = s8[i]; }
        run_phase(lp, ph, lds);
#endif
    }
}

extern "C" void kernel_launch(void* const* d_in, const int* in_sizes, int n_in, void* d_out, int out_size, void* d_ws, size_t ws_size, hipStream_t stream) {
    static int grid = 0;
    if (grid == 0) {
        if (ws_size < WS_TOTAL) { fprintf(stderr, "kernel_launch: workspace too small (%zu < %zu)\n", ws_size, (size_t)WS_TOTAL); grid = -1; return; }
        int dev = 0, cus = 0, per_cu = 0;
        hipGetDevice(&dev);
        hipDeviceGetAttribute(&cus, hipDeviceAttributeMultiprocessorCount, dev);
        if (hipFuncSetAttribute((const void*)mega_fwd, hipFuncAttributeMaxDynamicSharedMemorySize, LDS_BYTES) != hipSuccess) fprintf(stderr, "kernel_launch: hipFuncSetAttribute failed\n");
        if (hipOccupancyMaxActiveBlocksPerMultiprocessor(&per_cu, (const void*)mega_fwd, NT, LDS_BYTES) != hipSuccess || per_cu < 1) { fprintf(stderr, "kernel_launch: occupancy query gave %d\n", per_cu); per_cu = 1; }
        (void)hipGetLastError();
        grid = cus * per_cu;
        fprintf(stderr, "kernel_launch: grid %d (cus %d x %d)\n", grid, cus, per_cu);
    }
    if (grid < 0) return;
    (void)hipMemsetAsync((unsigned char*)d_ws + WS_BAR, 0, 16384, stream);
    Params p{};
    const float** f = (const float**)&p;
    for (int i = 0; i < 21; ++i) f[i] = (const float*)d_in[i];
    p.out = (float*)d_out; p.ws = (unsigned char*)d_ws;
#if N_LAUNCH_SPLIT
    for (int ph = 0; ph < NPH; ++ph) { p.ph_lo = ph; p.ph_hi = ph + 1; hipLaunchKernelGGL(mega_fwd, dim3(grid), dim3(NT), LDS_BYTES, stream, p); }
#else
    p.ph_lo = 0; p.ph_hi = NPH;
    void* args[] = {&p};
    hipError_t e = hipLaunchCooperativeKernel((const void*)mega_fwd, dim3(grid), dim3(NT), args, LDS_BYTES, stream);
    if (e != hipSuccess) fprintf(stderr, "kernel_launch: cooperative launch failed: %s (grid %d)\n", hipGetErrorString(e), grid);
#endif
}
```

```cpp
#include <hip/hip_runtime.h>
#include <hip/hip_cooperative_groups.h>
#include <cstdio>
#include <cstdint>
namespace cg = cooperative_groups;

typedef unsigned short bf16_t;
typedef short bf16x8 __attribute__((ext_vector_type(8)));
typedef short bf16x4 __attribute__((ext_vector_type(4)));
typedef float f32x4 __attribute__((ext_vector_type(4)));
typedef unsigned u32x4 __attribute__((ext_vector_type(4)));
typedef unsigned u32x2 __attribute__((ext_vector_type(2)));

#define DEVI __device__ __forceinline__
#ifndef N_LAUNCH_SPLIT
#define N_LAUNCH_SPLIT 0
#endif

constexpr int NT = 512;
constexpr int DM = 1024, SEQ = 8192, CTXL = 256;
constexpr int TOKL = 16384, TOKC = 512, TOK = 16896;
constexpr int INW = 2080, INWP = 2304, FFH = 2816;
constexpr int NCI = 132;
constexpr int LDS_BYTES = 147456;

constexpr size_t SZ_WIN = (size_t)INWP * DM * 2, SZ_WOUT = (size_t)DM * DM * 2, SZ_WFI = (size_t)2 * FFH * DM * 2, SZ_WFO = (size_t)DM * FFH * 2;
constexpr size_t WS_WIN = 0;
constexpr size_t WS_WOUT = WS_WIN + 2 * SZ_WIN;
constexpr size_t WS_WFI = WS_WOUT + 2 * SZ_WOUT;
constexpr size_t WS_WFO = WS_WFI + 2 * SZ_WFI;
constexpr size_t WS_MOD = WS_WFO + 2 * SZ_WFO;
constexpr size_t WS_ROPE = WS_MOD + 2 * 3 * 6144 * 4;
constexpr size_t WS_D128 = WS_ROPE + 2 * 128 * 16 * 4;
constexpr size_t WS_T64 = WS_D128 + 256 * 128 * 2;
constexpr size_t WS_MMT = WS_T64 + 128 * 128 * 2;
constexpr size_t WS_XC = WS_MMT + 2 * 4 * 64 * 128 * 2;
constexpr size_t WS_DEC = WS_XC + (size_t)TOKC * DM * 4;
constexpr size_t WS_H = WS_DEC + (size_t)2 * 2 * NCI * 4 * 64 * 4;
constexpr size_t WS_MIX = WS_H + (size_t)TOK * DM * 2;
constexpr size_t WS_P = WS_MIX + (size_t)TOK * DM * 2;
constexpr size_t WS_VTL = WS_P + (size_t)TOK * INWP * 2;
constexpr size_t WS_VTC = WS_VTL + (size_t)2 * 2 * 64 * SEQ * 2;
constexpr size_t WS_YP = WS_VTC + (size_t)2 * 2 * 64 * CTXL * 2;
constexpr size_t WS_UT = WS_YP + (size_t)2 * 4 * 128 * 2 * 64 * 64 * 2;
constexpr size_t WS_END = WS_UT + (size_t)2 * 2 * NCI * 4 * 4096 * 2;
constexpr size_t WS_BAR = WS_END;
constexpr size_t WS_PART = WS_BAR + 16384;
constexpr size_t WS_YPC = WS_PART + (size_t)4 * TOKC * DM * 4;
constexpr size_t WS_LA = WS_YPC + (size_t)2 * 4 * 4 * 2 * 64 * 64 * 2;
constexpr size_t WS_TOTAL = WS_LA + (size_t)2 * NCI * 4 * 2 * 64 * 64 * 2;
constexpr size_t WS_HID = WS_P;
static_assert(WS_HID + (size_t)TOK * FFH * 2 <= WS_UT, "HID overlay");
static_assert(WS_TOTAL <= 268435456ull, "workspace");

struct Params {
    const float *x, *c, *ctx, *c_ctx, *w_mod, *b_mod, *g1, *w_in, *qg, *kg, *sink, *wf, *wgf, *bgf, *wgb, *bgb, *glag, *w_out, *g2, *w_fi, *w_fo;
    float* out; unsigned char* ws;
    int ph_lo, ph_hi;
};

DEVI int tidx() { int t = threadIdx.x; asm volatile("" : "+v"(t)); return t; }
typedef __bf16 bf16v2 __attribute__((ext_vector_type(2)));
DEVI unsigned pk2(float lo, float hi) { bf16v2 v = {(__bf16)lo, (__bf16)hi}; return __builtin_bit_cast(unsigned, v); }
DEVI bf16_t f2bf(float f) { return (bf16_t)(pk2(f, 0.f) & 0xffffu); }
DEVI float bf2f(bf16_t h) { return __uint_as_float(((unsigned)h) << 16); }
DEVI float bflo(unsigned u) { return __uint_as_float(u << 16); }
DEVI float bfhi(unsigned u) { return __uint_as_float(u & 0xffff0000u); }
DEVI f32x4 mfma16(bf16x8 a, bf16x8 b, f32x4 c) { return __builtin_amdgcn_mfma_f32_16x16x32_bf16(a, b, c, 0, 0, 0); }
DEVI void unpack8(u32x4 u, float* v) { v[0] = bflo(u.x); v[1] = bfhi(u.x); v[2] = bflo(u.y); v[3] = bfhi(u.y); v[4] = bflo(u.z); v[5] = bfhi(u.z); v[6] = bflo(u.w); v[7] = bfhi(u.w); }
DEVI u32x4 pack8(const float* v) { u32x4 o; o.x = pk2(v[0], v[1]); o.y = pk2(v[2], v[3]); o.z = pk2(v[4], v[5]); o.w = pk2(v[6], v[7]); return o; }
DEVI float dpp_xor1(float x) { return __uint_as_float((unsigned)__builtin_amdgcn_mov_dpp((int)__float_as_uint(x), 0xB1, 0xF, 0xF, true)); }
DEVI float dpp_xor2(float x) { return __uint_as_float((unsigned)__builtin_amdgcn_mov_dpp((int)__float_as_uint(x), 0x4E, 0xF, 0xF, true)); }
DEVI float red_max_16_32(float x) {
    auto r = __builtin_amdgcn_permlane16_swap(__float_as_uint(x), __float_as_uint(x), false, false); x = fmaxf(__uint_as_float(r[0]), __uint_as_float(r[1]));
    auto q = __builtin_amdgcn_permlane32_swap(__float_as_uint(x), __float_as_uint(x), false, false); return fmaxf(__uint_as_float(q[0]), __uint_as_float(q[1]));
}
DEVI float red_sum_16_32(float x) {
    auto r = __builtin_amdgcn_permlane16_swap(__float_as_uint(x), __float_as_uint(x), false, false); x = __uint_as_float(r[0]) + __uint_as_float(r[1]);
    auto q = __builtin_amdgcn_permlane32_swap(__float_as_uint(x), __float_as_uint(x), false, false); return __uint_as_float(q[0]) + __uint_as_float(q[1]);
}
DEVI bf16_t raw16(const u32x4 u, int i) { const unsigned w = (i >> 1) == 0 ? u.x : ((i >> 1) == 1 ? u.y : ((i >> 1) == 2 ? u.z : u.w)); return (bf16_t)((i & 1) ? (w >> 16) : (w & 0xffffu)); }
DEVI float silu_f(float v) { return v * __builtin_amdgcn_rcpf(1.f + __builtin_amdgcn_exp2f(v * -1.44269504f)); }

DEVI void transpose_tile(const float* __restrict__ W, int N, int Nvalid, bf16_t* __restrict__ WT, int Kdst, int k0, int n0, int mode, float* tile) {
    const int t = tidx();
    __syncthreads();
    {
        const int c4 = (t & 63) * 4;
        float4 v[8];
#pragma unroll
        for (int i = 0; i < 8; ++i) { const int kk = (t >> 6) + 8 * i; v[i] = make_float4(0.f, 0.f, 0.f, 0.f); if (n0 + c4 < Nvalid) v[i] = *(const float4*)(W + (size_t)(k0 + kk) * N + n0 + c4); }
#pragma unroll
        for (int i = 0; i < 8; ++i) { const int kk = (t >> 6) + 8 * i; tile[kk * 257 + c4 + 0] = v[i].x; tile[kk * 257 + c4 + 1] = v[i].y; tile[kk * 257 + c4 + 2] = v[i].z; tile[kk * 257 + c4 + 3] = v[i].w; }
    }
    __syncthreads();
    const int nn = t >> 1, ks = (t & 1) * 32;
    const int n = n0 + nn;
    int orow = n;
    if (mode == 1) { if (n < FFH) orow = (n >> 7) * 256 + (n & 127); else { const int j = n - FFH; orow = (j >> 7) * 256 + 128 + (j & 127); } }
    { const int q5 = orow & 31; orow = (orow & ~31) + ((q5 >> 2) & 1) * 16 + (q5 >> 3) * 4 + (q5 & 3); }
#pragma unroll
    for (int q = 0; q < 4; ++q) {
        float v[8];
#pragma unroll
        for (int j = 0; j < 8; ++j) v[j] = tile[(ks + q * 8 + j) * 257 + nn];
        *(u32x4*)(WT + (size_t)orow * Kdst + k0 + ks + q * 8) = pack8(v);
    }
}

DEVI void prep_phase(const Params& p, unsigned char* lds, const int lsel = 0, const int bid0 = 0, const int nblk = 0) {
    const int t = tidx();
    constexpr int PER_L = 144 + 64 + 352 + 176;
    constexpr int N_MOD = 192, N_TAB = 9;
    const int NITEMS = N_MOD + N_TAB + (lsel == 0 ? 208 : (lsel == 4 ? 208 : 528));
    float* fl = (float*)lds;
    const int it0 = lsel ? N_MOD + N_TAB + ((int)blockIdx.x - bid0) : (int)blockIdx.x, itstep = lsel ? nblk : (int)gridDim.x;
    for (int it = it0; it < NITEMS; it += itstep) {
        if (it < N_MOD) {
            const int l = it / 96, j0 = (it % 96) * 64;
            float* sc = fl; float* red = fl + 3072;
            __syncthreads();
            for (int i = t; i < 3072; i += NT) { const int v = i >> 10, k = i & 1023; const float cv = v < 2 ? p.c[v * 1024 + k] : p.c_ctx[k]; sc[i] = cv / (1.f + expf(-cv)); }
            __syncthreads();
            const int jj = t & 63, kg = t >> 6;
            const float* w = p.w_mod + (size_t)l * 1024 * 6144 + j0 + jj;
            float a0 = 0.f, a1 = 0.f, a2 = 0.f;
#pragma unroll 1
            for (int k0 = kg * 128; k0 < kg * 128 + 128; k0 += 32) {
                float wv[32];
#pragma unroll
                for (int i = 0; i < 32; ++i) wv[i] = w[(size_t)(k0 + i) * 6144];
#pragma unroll
                for (int i = 0; i < 32; ++i) { a0 += sc[k0 + i] * wv[i]; a1 += sc[1024 + k0 + i] * wv[i]; a2 += sc[2048 + k0 + i] * wv[i]; }
            }
            red[(kg * 3 + 0) * 64 + jj] = a0; red[(kg * 3 + 1) * 64 + jj] = a1; red[(kg * 3 + 2) * 64 + jj] = a2;
            __syncthreads();
            if (t < 192) {
                const int v = t >> 6, j = t & 63; float s = 0.f;
#pragma unroll
                for (int g = 0; g < 8; ++g) s += red[(g * 3 + v) * 64 + j];
                ((float*)(p.ws + WS_MOD))[(l * 3 + v) * 6144 + j0 + j] = s + p.b_mod[l * 6144 + j0 + j];
            }
        } else if (it < N_MOD + N_TAB) {
            const int ti = it - N_MOD;
            if (ti == 0) {
                float* rope = (float*)(p.ws + WS_ROPE);
                for (int i = t; i < 128 * 16; i += NT) { const int pos = i >> 4, f = i & 15; const float inv = powf(10000.f, -(float)(2 * f) / 32.f); const float ang = (float)pos * inv; rope[i] = cosf(ang); rope[2048 + i] = sinf(ang); }
                bf16_t* d128 = (bf16_t*)(p.ws + WS_D128);
                for (int i = t; i < 256 * 128; i += NT) { const int r = i >> 7, n1 = i & 127; const int part = (r >> 4) & 1, k1 = (r >> 5) * 16 + (r & 15); const int m = (n1 * k1) & 127; const float a = (float)m / 64.f; d128[i] = f2bf(part == 0 ? cospif(a) : -sinpif(a)); }
                bf16_t* t64 = (bf16_t*)(p.ws + WS_T64);
                for (int i = t; i < 128 * 128; i += NT) { const int r = i >> 7, kk = i & 127; const int mt = r >> 4, po = mt & 1, k2 = (mt >> 1) * 16 + (r & 15), part = kk >> 6, n2 = kk & 63; const int m = (n2 * k2) & 63; const float a = (float)m / 32.f; const float cs = cospif(a), sn = sinpif(a);
                    t64[i] = f2bf(po == 0 ? (part == 0 ? cs : sn) : (part == 0 ? -sn : cs)); }
            } else {
                const int l = (ti - 1) >> 2, g = (ti - 1) & 3;
                const float* wf = p.wf + (size_t)(l * 4 + g) * 4096;
                bf16_t* mmt = (bf16_t*)(p.ws + WS_MMT) + (size_t)(l * 4 + g) * 8192;
                const float nrm = 1.0f / sqrtf(8192.f * 64.f);
                __syncthreads();
                if (t < 64) { fl[t] = cospif((float)t / 32.f); fl[64 + t] = sinpif((float)t / 32.f); }
                for (int i = t; i < 4096; i += NT) fl[128 + i] = wf[i];
                __syncthreads();
                for (int i = t; i < 8192; i += NT) { const int e = i >> 7, cp = i & 127, part = cp >> 6, c = cp & 63; float s = 0.f;
#pragma unroll 8
                    for (int e0 = 0; e0 < 64; ++e0) s += fl[part * 64 + ((c * e0) & 63)] * fl[128 + e0 * 64 + e];
                    mmt[i] = f2bf(s * nrm); }
            }
        } else {
            int r = it - N_MOD - N_TAB; int l = 0;
            if (lsel == 1) r += 208;
            else if (lsel == 2) { r += 208; l = 1; }
            else if (lsel == 4) l = 1;
            if (r < 144) { transpose_tile(p.w_in + (size_t)l * DM * INW, INW, INW, (bf16_t*)(p.ws + WS_WIN + l * SZ_WIN), DM, (r / 9) * 64, (r % 9) * 256, 0, fl); continue; } r -= 144;
            if (r < 64) { transpose_tile(p.w_out + (size_t)l * DM * DM, DM, DM, (bf16_t*)(p.ws + WS_WOUT + l * SZ_WOUT), DM, (r / 4) * 64, (r % 4) * 256, 0, fl); continue; } r -= 64;
            if (r < 352) { transpose_tile(p.w_fi + (size_t)l * DM * 2 * FFH, 2 * FFH, 2 * FFH, (bf16_t*)(p.ws + WS_WFI + l * SZ_WFI), DM, (r / 22) * 64, (r % 22) * 256, 1, fl); continue; } r -= 352;
            transpose_tile(p.w_fo + (size_t)l * FFH * DM, DM, DM, (bf16_t*)(p.ws + WS_WFO + l * SZ_WFO), FFH, (r / 4) * 64, (r % 4) * 256, 0, fl);
        }
    }
}

DEVI void norm_phase(const Params& p, int l, int which) {
    const int lane = tidx() & 63, wave = tidx() >> 6;
    const int nrows = (which == 1 && l == 1) ? TOKL : TOK;
    const float* MOD = (const float*)(p.ws + WS_MOD);
    const float* XC = (const float*)(p.ws + WS_XC);
    bf16_t* H = (bf16_t*)(p.ws + WS_H);
    const float* g = (which ? p.g2 : p.g1) + l * DM;
    for (int r = blockIdx.x * 8 + wave; r < nrows; r += gridDim.x * 8) {
        const float* src; int vec;
        if (r < TOKL) { src = ((which == 0 && l == 0) ? p.x : p.out) + (size_t)r * DM; vec = r >> 13; }
        else { const int rc = r - TOKL; src = ((which == 0 && l == 0) ? p.ctx : XC) + (size_t)rc * DM; vec = 2; }
        const float* mod = MOD + (l * 3 + vec) * 6144;
        const float* sh = mod + (which ? 3 * DM : 0);
        const float* sc = mod + (which ? 4 * DM : DM);
        f32x4 v[4]; float ss = 0.f;
        const bool fold = (r >= TOKL) && ((which == 1 && l == 0) || (which == 0 && l == 1));
#pragma unroll
        for (int j = 0; j < 4; ++j) {
            v[j] = *(const f32x4*)(src + j * 256 + lane * 4);
            if (fold) {
                const float* pb = (const float*)(p.ws + WS_PART) + (size_t)(r - TOKL) * DM + j * 256 + lane * 4;
#pragma unroll
                for (int s = 0; s < 4; ++s) v[j] += *(const f32x4*)(pb + (size_t)s * TOKC * DM);
                *(f32x4*)((float*)(p.ws + WS_XC) + (size_t)(r - TOKL) * DM + j * 256 + lane * 4) = v[j];
            }
            ss += v[j].x * v[j].x + v[j].y * v[j].y + v[j].z * v[j].z + v[j].w * v[j].w;
        }
#pragma unroll
        for (int o = 1; o < 64; o <<= 1) ss += __shfl_xor(ss, o);
        const float rstd = rsqrtf(ss * (1.f / DM) + 1e-6f);
#pragma unroll
        for (int j = 0; j < 4; ++j) {
            const int k = j * 256 + lane * 4;
            const f32x4 gv = *(const f32x4*)(g + k), sv = *(const f32x4*)(sc + k), hv = *(const f32x4*)(sh + k);
            const f32x4 y = (v[j] * rstd) * gv * (sv + 1.f) + hv;
            u32x2 o; o.x = pk2(y.x, y.y); o.y = pk2(y.z, y.w);
            *(u32x2*)(H + (size_t)r * DM + k) = o;
            if (which == 0 && l == 0 && r >= TOKL) *(f32x4*)((float*)(p.ws + WS_XC) + (size_t)(r - TOKL) * DM + k) = v[j];
        }
    }
}

template <class Epi>
DEVI void gemm_phase(const bf16_t* __restrict__ A, const bf16_t* __restrict__ Bt, int K, int nM, int nN, const Epi& epi, unsigned char* lds) {
    bf16_t* As = (bf16_t*)lds; bf16_t* Bs = As + 256 * 72;
    const int t = tidx(), lane = t & 63, wid = t >> 6, wr = wid >> 2, wc = wid & 3, fr = lane & 15, fq = lane >> 4;
    const int ntile = nM * nN;
    for (int tile = blockIdx.x; tile < ntile; tile += gridDim.x) {
        const int pm = tile / nN, pn = tile % nN;
        f32x4 acc[2][2][4][2];
#pragma unroll
        for (int ai = 0; ai < 2; ++ai)
#pragma unroll
            for (int bj = 0; bj < 2; ++bj)
#pragma unroll
                for (int m = 0; m < 4; ++m)
#pragma unroll
                    for (int n = 0; n < 2; ++n) acc[ai][bj][m][n] = (f32x4){0.f, 0.f, 0.f, 0.f};
        const bf16_t* Ab = A + (size_t)pm * 256 * K; const bf16_t* Bb = Bt + (size_t)pn * 256 * K;
        for (int k0 = 0; k0 < K; k0 += 64) {
            u32x4 ra[4], rb[4];
#pragma unroll
            for (int i = 0; i < 4; ++i) { const int id = i * NT + t, row = id >> 3, seg = id & 7; ra[i] = *(const u32x4*)(Ab + (size_t)row * K + k0 + seg * 8); rb[i] = *(const u32x4*)(Bb + (size_t)row * K + k0 + seg * 8); }
            __syncthreads();
#pragma unroll
            for (int i = 0; i < 4; ++i) { const int id = i * NT + t, row = id >> 3, seg = id & 7; *(u32x4*)(As + row * 72 + seg * 8) = ra[i]; *(u32x4*)(Bs + row * 72 + seg * 8) = rb[i]; }
            __syncthreads();
#pragma unroll
            for (int ks = 0; ks < 2; ++ks) {
                bf16x8 af[2][4], bfg[2][2];
#pragma unroll
                for (int ai = 0; ai < 2; ++ai)
#pragma unroll
                    for (int m = 0; m < 4; ++m) af[ai][m] = *(const bf16x8*)(As + (ai * 128 + wr * 64 + m * 16 + fr) * 72 + ks * 32 + fq * 8);
#pragma unroll
                for (int bj = 0; bj < 2; ++bj)
#pragma unroll
                    for (int n = 0; n < 2; ++n) bfg[bj][n] = *(const bf16x8*)(Bs + (bj * 128 + wc * 32 + n * 16 + fr) * 72 + ks * 32 + fq * 8);
#pragma unroll
                for (int ai = 0; ai < 2; ++ai)
#pragma unroll
                    for (int bj = 0; bj < 2; ++bj)
#pragma unroll
                        for (int m = 0; m < 4; ++m)
#pragma unroll
                            for (int n = 0; n < 2; ++n) acc[ai][bj][m][n] = mfma16(bfg[bj][n], af[ai][m], acc[ai][bj][m][n]);
            }
        }
        epi(acc, pm, pn, wr, wc, fr, fq);
    }
}


typedef __attribute__((address_space(3))) unsigned char ldsb_t;
typedef __attribute__((address_space(3))) unsigned ldsu_t;
DEVI int g8_lds_byte(int r, int c) { const int st = (r >> 4) * 2 + (c >> 5), rr = r & 15, cc = c & 31, ob = rr * 64 + cc * 2; return st * 1024 + (ob ^ (((ob >> 9) & 1) << 5)); }
DEVI void g8_stage_rc(int b, int& R, int& C) { const int st = b / 1024, sb = b % 1024, swz = sb ^ (((sb >> 9) & 1) << 5); R = (st >> 1) * 16 + swz / 64; C = (st & 1) * 32 + (swz % 64) / 2; }
#define G8_SA(b, h) (shm + ((b) * 2 + (h)) * 16384)
#define G8_SB(b, h) (shm + (4 + (b) * 2 + (h)) * 16384)
#define G8_STAGE(Pp, BASE, br, kt) do { const char* _g = (const char*)((BASE) + (long)(br) * K + (long)(kt) * 64); \
    __builtin_amdgcn_global_load_lds((const unsigned*)(_g + so0), (ldsu_t*)((Pp) + wdst), 16, 0, 0); \
    __builtin_amdgcn_global_load_lds((const unsigned*)(_g + (size_t)128 * K + so0), (ldsu_t*)((Pp) + wdst + 8192), 16, 0, 0); } while (0)
#define G8_LDA(b, h) _Pragma("unroll") for (int m = 0; m < 4; ++m) _Pragma("unroll") for (int k = 0; k < 2; ++k) At[m][k] = *(const __attribute__((address_space(3))) bf16x8*)(G8_SA(b, h) + aoff + m * 2048 + k * 1024)
#define G8_LDB(dst, b, h) _Pragma("unroll") for (int n = 0; n < 2; ++n) _Pragma("unroll") for (int k = 0; k < 2; ++k) dst[n][k] = *(const __attribute__((address_space(3))) bf16x8*)(G8_SB(b, h) + boff + n * 2048 + k * 1024)
#define G8_MMA(ai, bj, Bx) do { __builtin_amdgcn_s_setprio(1); \
    _Pragma("unroll") for (int m = 0; m < 4; ++m) _Pragma("unroll") for (int n = 0; n < 2; ++n) _Pragma("unroll") for (int k = 0; k < 2; ++k) \
        acc[ai][bj][m][n] = __builtin_amdgcn_mfma_f32_16x16x32_bf16(Bx[n][k], At[m][k], acc[ai][bj][m][n], 0, 0, 0); \
    __builtin_amdgcn_s_setprio(0); } while (0)
#define G8_WV(n) asm volatile("s_waitcnt vmcnt(" #n ")" ::: "memory")
#define G8_WL(n) asm volatile("s_waitcnt lgkmcnt(" #n ")" ::: "memory")
#define G8_BAR __builtin_amdgcn_s_barrier()
#define G8_SCHED __builtin_amdgcn_sched_barrier(0)

template <class Epi>
DEVI void gemm_phase8(const bf16_t* __restrict__ A, const bf16_t* __restrict__ Bt, const int K, const int nM, const int nN, const Epi& epi, unsigned char* lds, const int nsplit = 0) {
    ldsb_t* shm = (ldsb_t*)lds;
    const int t = tidx(), lane = t & 63, wid = t >> 6, wr = wid >> 2, wc = wid & 3, fr = lane & 15, fq = lane >> 4;
    unsigned so0;
    { int r, c; g8_stage_rc(t * 16, r, c); so0 = (unsigned)(r * K + c) * 2u; }
    const int wdst = __builtin_amdgcn_readfirstlane(wid * 1024);
    const int loff = g8_lds_byte(fr, fq * 8);
    const int aoff = loff + wr * 8192, boff = loff + wc * 4096;
    const int nwg = nM * nN, G = gridDim.x, ntk = K / 64;
    const int nunits = nwg + 2 * nN * nsplit;
    auto decode = [&](long L, int& pm, int& pn, int& kbeg, int& nt, int& part) {
        kbeg = 0; nt = ntk; part = -1;
        if (L < nwg) {
            int wgid = (int)L; { const int q = nwg / 8, r = nwg % 8, xcd = wgid % 8, off = wgid / 8; wgid = (xcd < r ? xcd * (q + 1) : r * (q + 1) + (xcd - r) * q) + off; }
            const int nig = 8 * nN, gid = wgid / nig, fm = gid * 8, gsz = (nM - fm) < 8 ? (nM - fm) : 8;
            pm = fm + ((wgid % nig) % gsz); pn = (wgid % nig) / gsz;
        } else {
            const int v = (int)L - nwg, sp = v % nsplit, tl = v / nsplit;
            pm = 64 + tl / nN; pn = tl % nN; part = sp;
            const int base = (ntk / nsplit) & ~1, extra = (ntk - base * nsplit) / 2;
            nt = base + (sp < extra ? 2 : 0); kbeg = sp * base + 2 * (sp < extra ? sp : extra);
        }
    };
    int pm = 0, pn = 0, kbeg = 0, nt = ntk, part = -1;
    if ((long)blockIdx.x >= nunits) return;
    decode(blockIdx.x, pm, pn, kbeg, nt, part);
    const bf16_t* Au = A + (size_t)pm * 256 * K + (size_t)kbeg * 64; const bf16_t* Bu = Bt + (size_t)pn * 256 * K + (size_t)kbeg * 64;
    f32x4 acc[2][2][4][2];
#pragma unroll
    for (int ai = 0; ai < 2; ++ai)
#pragma unroll
        for (int bj = 0; bj < 2; ++bj)
#pragma unroll
            for (int m = 0; m < 4; ++m)
#pragma unroll
                for (int n = 0; n < 2; ++n) acc[ai][bj][m][n] = (f32x4){0.f, 0.f, 0.f, 0.f};
    bf16x8 At[4][2], B0[2][2], B1[2][2];
    G8_WV(0);
    G8_STAGE(G8_SB(0, 0), Bu, 0, 0); G8_STAGE(G8_SB(0, 1), Bu, 128, 0); G8_STAGE(G8_SA(0, 0), Au, 0, 0); G8_STAGE(G8_SA(0, 1), Au, 128, 0);
    if (wr == 1) G8_BAR;
    G8_WV(2); G8_BAR;
    G8_STAGE(G8_SB(1, 0), Bu, 0, 1); G8_STAGE(G8_SA(1, 0), Au, 0, 1); G8_STAGE(G8_SB(1, 1), Bu, 128, 1);
    G8_WV(6); G8_BAR;
    for (int it = 0;; ++it) {
        int npm = pm, npn = pn, nkbeg = kbeg, nnt = nt, npart = part;
        const long Ln = (long)(it + 1) * G + blockIdx.x; const bool has_next = Ln < nunits;
        if (has_next) decode(Ln, npm, npn, nkbeg, nnt, npart);
        const bf16_t* nAu = has_next ? A + (size_t)npm * 256 * K + (size_t)nkbeg * 64 : Au; const bf16_t* nBu = has_next ? Bt + (size_t)npn * 256 * K + (size_t)nkbeg * 64 : Bu;
        for (int kt = 0; kt < nt; kt += 2) {
            const bool lastk = (kt == nt - 2);
            const bf16_t* A2 = lastk ? nAu : Au; const bf16_t* B2 = lastk ? nBu : Bu; const int k2 = lastk ? 0 : kt + 2;
            G8_LDB(B0, 0, 0); G8_LDB(B1, 0, 1); G8_SCHED; G8_LDA(0, 0); G8_STAGE(G8_SA(1, 1), Au, 128, kt + 1);
            G8_WV(8); G8_WL(0); G8_BAR; G8_MMA(0, 0, B0); G8_MMA(0, 1, B1); G8_BAR; G8_SCHED;
            G8_LDA(0, 1); G8_STAGE(G8_SB(0, 0), B2, 0, k2); G8_STAGE(G8_SB(0, 1), B2, 128, k2); G8_STAGE(G8_SA(0, 0), A2, 0, k2);
            G8_WV(8); G8_WL(0); G8_BAR; G8_MMA(1, 0, B0); G8_MMA(1, 1, B1); G8_BAR; G8_SCHED;
            G8_LDB(B0, 1, 0); G8_LDB(B1, 1, 1); G8_SCHED; G8_LDA(1, 0); G8_STAGE(G8_SA(0, 1), A2, 128, k2);
            G8_WV(8); G8_WL(0); G8_BAR; G8_MMA(0, 0, B0); G8_MMA(0, 1, B1); G8_BAR; G8_SCHED;
            G8_LDA(1, 1); G8_STAGE(G8_SB(1, 0), B2, 0, k2 + 1); G8_STAGE(G8_SB(1, 1), B2, 128, k2 + 1); G8_STAGE(G8_SA(1, 0), A2, 0, k2 + 1);
            G8_WV(8); G8_WL(0); G8_BAR; G8_MMA(1, 0, B0); G8_MMA(1, 1, B1); G8_BAR; G8_SCHED;
        }
        if (wr == 0) G8_BAR;
        epi(acc, pm, pn, wr, wc, fr, fq, part);
        if (!has_next) break;
#pragma unroll
        for (int ai = 0; ai < 2; ++ai)
#pragma unroll
            for (int bj = 0; bj < 2; ++bj)
#pragma unroll
                for (int m = 0; m < 4; ++m)
#pragma unroll
                    for (int n = 0; n < 2; ++n) acc[ai][bj][m][n] = (f32x4){0.f, 0.f, 0.f, 0.f};
        pm = npm; pn = npn; kbeg = nkbeg; nt = nnt; part = npart; Au = nAu; Bu = nBu;
        if (wr == 1) G8_BAR;
    }
    G8_WV(0);
    G8_BAR;
}


struct EpiInProj {
    bf16_t* P; bf16_t* VTL; bf16_t* VTC;
    DEVI void operator()(const f32x4 (&acc)[2][2][4][2], int pm, int pn, int wr, int wc, int fr, int fq, int part = -1) const {
#pragma unroll
        for (int ai = 0; ai < 2; ++ai)
#pragma unroll
            for (int m = 0; m < 4; ++m) {
                const int r = pm * 256 + ai * 128 + wr * 64 + m * 16 + fr;
#pragma unroll
                for (int bj = 0; bj < 2; ++bj) {
                    const int c = pn * 256 + bj * 128 + wc * 32 + fq * 8;
                    const f32x4 v0 = acc[ai][bj][m][0], v1 = acc[ai][bj][m][1];
                    if (pn == 2 && bj == 1) {
                        const int di = c - 640, kvh = di >> 6, d = di & 63;
                        bf16_t* dst; int stride;
                        if (r < TOKL) { const int b = r >> 13, tt = r & 8191; dst = VTL + ((size_t)((b * 2 + kvh) * 64 + d)) * SEQ + tt; stride = SEQ; }
                        else { const int rc = r - TOKL, b = rc >> 8, tt = rc & 255; dst = VTC + ((size_t)((b * 2 + kvh) * 64 + d)) * CTXL + tt; stride = CTXL; }
                        dst[0] = f2bf(v0.x); dst[stride] = f2bf(v0.y); dst[2 * stride] = f2bf(v0.z); dst[3 * stride] = f2bf(v0.w);
                        dst[4 * stride] = f2bf(v1.x); dst[5 * stride] = f2bf(v1.y); dst[6 * stride] = f2bf(v1.z); dst[7 * stride] = f2bf(v1.w);
                    } else {
                        u32x4 o; o.x = pk2(v0.x, v0.y); o.y = pk2(v0.z, v0.w); o.z = pk2(v1.x, v1.y); o.w = pk2(v1.z, v1.w);
                        *(u32x4*)(P + (size_t)r * INWP + c) = o;
                    }
                }
            }
    }
};
struct EpiResid {
    const float* baseL; const float* baseC; float* outL; float* outC; const float* mod; int goff; float* partbuf;
    DEVI void operator()(const f32x4 (&acc)[2][2][4][2], int pm, int pn, int wr, int wc, int fr, int fq, int part = -1) const {
        const int vec = pm < 32 ? 0 : (pm < 64 ? 1 : 2);
        const int r0 = pm * 256 + wr * 64 + fr, c0 = pn * 256 + wc * 32 + fq * 8;
        const float* gt = mod + vec * 6144 + goff + c0;
        f32x4 gv[2][2];
#pragma unroll
        for (int bj = 0; bj < 2; ++bj)
#pragma unroll
            for (int n = 0; n < 2; ++n) gv[bj][n] = *(const f32x4*)(gt + bj * 128 + n * 4);
        if (part >= 0) {
#pragma unroll
            for (int ai = 0; ai < 2; ++ai)
#pragma unroll
                for (int m = 0; m < 4; ++m)
#pragma unroll
                    for (int bj = 0; bj < 2; ++bj)
#pragma unroll
                        for (int n = 0; n < 2; ++n)
                            *(f32x4*)(partbuf + ((size_t)part * TOKC + (r0 + ai * 128 + m * 16 - TOKL)) * DM + c0 + bj * 128 + n * 4) = gv[bj][n] * acc[ai][bj][m][n];
            return;
        }
        const float* base = pm < 64 ? baseL + (size_t)r0 * DM + c0 : baseC + (size_t)(r0 - TOKL) * DM + c0;
        float* dst = pm < 64 ? outL + (size_t)r0 * DM + c0 : outC + (size_t)(r0 - TOKL) * DM + c0;
#pragma unroll
        for (int ai = 0; ai < 2; ++ai) {
            f32x4 bv[4][2][2];
#pragma unroll
            for (int m = 0; m < 4; ++m)
#pragma unroll
                for (int bj = 0; bj < 2; ++bj)
#pragma unroll
                    for (int n = 0; n < 2; ++n) bv[m][bj][n] = *(const f32x4*)(base + (size_t)(ai * 128 + m * 16) * DM + bj * 128 + n * 4);
#pragma unroll
            for (int m = 0; m < 4; ++m)
#pragma unroll
                for (int bj = 0; bj < 2; ++bj)
#pragma unroll
                    for (int n = 0; n < 2; ++n) *(f32x4*)(dst + (size_t)(ai * 128 + m * 16) * DM + bj * 128 + n * 4) = bv[m][bj][n] + gv[bj][n] * acc[ai][bj][m][n];
        }
    }
};
struct EpiSwiglu {
    bf16_t* HID;
    DEVI void operator()(const f32x4 (&acc)[2][2][4][2], int pm, int pn, int wr, int wc, int fr, int fq, int part = -1) const {
#pragma unroll
        for (int ai = 0; ai < 2; ++ai)
#pragma unroll
            for (int m = 0; m < 4; ++m) {
                const int r = pm * 256 + ai * 128 + wr * 64 + m * 16 + fr;
                const int c = pn * 128 + wc * 32 + fq * 8;
                const f32x4 g0 = acc[ai][0][m][0], u0 = acc[ai][1][m][0], g1 = acc[ai][0][m][1], u1 = acc[ai][1][m][1];
                u32x4 o; o.x = pk2(silu_f(g0.x) * u0.x, silu_f(g0.y) * u0.y); o.y = pk2(silu_f(g0.z) * u0.z, silu_f(g0.w) * u0.w);
                o.z = pk2(silu_f(g1.x) * u1.x, silu_f(g1.y) * u1.y); o.w = pk2(silu_f(g1.z) * u1.z, silu_f(g1.w) * u1.w);
                *(u32x4*)(HID + (size_t)r * FFH + c) = o;
            }
    }
};

constexpr int ROPE_LDS_OFF = 114688;
DEVI void stage_norm_rope(const u32x4 raw, int row, int seg, const float* __restrict__ gn, bool rope, int pos, const float* ropel, float scale, bf16_t* dst) {
    float v[8]; unpack8(raw, v);
    float ss = 0.f;
#pragma unroll
    for (int j = 0; j < 8; ++j) ss += v[j] * v[j];
    ss += dpp_xor1(ss); ss += dpp_xor2(ss); ss += __shfl_xor(ss, 4);
    const float rstd = rsqrtf(ss * (1.f / 64.f) + 1e-6f);
    const f32x4 g0 = *(const f32x4*)(gn + seg * 8), g1 = *(const f32x4*)(gn + seg * 8 + 4);
    const float gg[8] = {g0.x, g0.y, g0.z, g0.w, g1.x, g1.y, g1.z, g1.w};
#pragma unroll
    for (int j = 0; j < 8; ++j) v[j] = v[j] * rstd * gg[j];
    float o[8];
    if (rope) {
        const int ap = (seg < 4) ? (pos >> 6) : (pos & 63);
        const float* tb = ropel + ap * 16 + (seg & 1) * 8;
        const f32x4 c0 = *(const f32x4*)tb, c1 = *(const f32x4*)(tb + 4), s0 = *(const f32x4*)(tb + 2048), s1 = *(const f32x4*)(tb + 2052);
        const float cs[8] = {c0.x, c0.y, c0.z, c0.w, c1.x, c1.y, c1.z, c1.w}, sn[8] = {s0.x, s0.y, s0.z, s0.w, s1.x, s1.y, s1.z, s1.w};
#pragma unroll
        for (int j = 0; j < 8; ++j) { const float pv = dpp_xor2(v[j]); o[j] = ((seg & 2) ? (v[j] * cs[j] + pv * sn[j]) : (v[j] * cs[j] - pv * sn[j])) * scale; }
    } else {
#pragma unroll
        for (int j = 0; j < 8; ++j) o[j] = v[j] * scale;
    }
    *(u32x4*)(dst + row * 72 + seg * 8) = pack8(o);
}

DEVI void attn_item(const Params& p, int l, int item, unsigned char* lds) {
    const int t = tidx(), lane = t & 63, wid = t >> 6, fr = lane & 15, fq = lane >> 4;
    const bf16_t* P = (const bf16_t*)(p.ws + WS_P);
    const bf16_t* VTL = (const bf16_t*)(p.ws + WS_VTL);
    const bf16_t* VTC = (const bf16_t*)(p.ws + WS_VTC);
    bf16_t* MIX = (bf16_t*)(p.ws + WS_MIX);
    const float* ropel = (const float*)(lds + ROPE_LDS_OFF);
    const float* qg = p.qg + l * 64; const float* kgn = p.kg + l * 64;
    bf16_t* Qs = (bf16_t*)lds;
    bf16_t* Ks = Qs + 512 * 72;
    bf16_t* Vs = Ks + 64 * 72;
    int b, qb, kvh; bool isctx; int qrow0;
    if (item < 256) { isctx = false; b = item >> 7; qb = (item >> 1) & 63; kvh = item & 1; qrow0 = b * SEQ + qb * 128; }
    else { const int ci = item - 256; isctx = true; b = ci >> 2; qb = (ci >> 1) & 1; kvh = ci & 1; qrow0 = TOKL + b * CTXL + qb * 128; }
    const int lo = isctx ? 0 : (qb * 2 - 2 < 0 ? 0 : qb * 2 - 2), hi = isctx ? -1 : (qb * 2 + 3 > 127 ? 127 : qb * 2 + 3);
    const int nl = hi - lo + 1, ntile = nl + 4;
    const int key = t >> 3, seg = t & 7;
    const size_t vrow = (size_t)((b * 2 + kvh) * 64 + key);
    u32x4 kraw, vraw;
    {
        const bool loc0 = nl > 0; const int kt0 = loc0 ? lo : 0;
        const size_t krow = loc0 ? ((size_t)b * SEQ + kt0 * 64 + key) : ((size_t)TOKL + b * CTXL + kt0 * 64 + key);
        kraw = *(const u32x4*)(P + krow * INWP + 512 + kvh * 64 + seg * 8);
        vraw = *(const u32x4*)(loc0 ? (VTL + vrow * SEQ + kt0 * 64 + seg * 8) : (VTC + vrow * CTXL + kt0 * 64 + seg * 8));
    }
    __syncthreads();
    {
        u32x4 qraw[8];
#pragma unroll
        for (int i = 0; i < 8; ++i) { const int id = i * NT + t, row = id >> 3, g = row >> 7, rr = row & 127; qraw[i] = *(const u32x4*)(P + (size_t)(qrow0 + rr) * INWP + (kvh * 4 + g) * 64 + (id & 7) * 8); }
#pragma unroll
        for (int i = 0; i < 8; ++i) { const int id = i * NT + t, row = id >> 3, rr = row & 127; stage_norm_rope(qraw[i], row, id & 7, qg, !isctx, qb * 128 + rr, ropel, 0.125f * 1.44269504f, Qs); }
    }
    {
        const bool loc0 = nl > 0; const int kt0 = loc0 ? lo : 0;
        stage_norm_rope(kraw, key, seg, kgn, loc0, kt0 * 64 + key, ropel, 1.f, Ks);
        *(u32x4*)(Vs + key * 72 + seg * 8) = vraw;
    }
    __syncthreads();
    const int g = wid >> 1, half = wid & 1;
    const bf16_t* Qw = Qs + (g * 128 + half * 64 + fr) * 72 + fq * 8;
    const float sinkv = p.sink[l * 8 + kvh * 4 + g] * 1.44269504f;
    float mrun[4], lrun[4]; f32x4 o[4][4];
#pragma unroll
    for (int n = 0; n < 4; ++n) { mrun[n] = sinkv; lrun[n] = fq == 0 ? 1.f : 0.f;
#pragma unroll
        for (int dt = 0; dt < 4; ++dt) o[dt][n] = (f32x4){0.f, 0.f, 0.f, 0.f}; }
    for (int ti = 0; ti < ntile; ++ti) {
        const bool local = ti < nl; const int kt = local ? lo + ti : ti - nl;
        const bool more = ti + 1 < ntile;
        const bool nloc = (ti + 1) < nl; const int nkt = nloc ? lo + ti + 1 : ti + 1 - nl;
        if (more) {
            const size_t krow = nloc ? ((size_t)b * SEQ + nkt * 64 + key) : ((size_t)TOKL + b * CTXL + nkt * 64 + key);
            kraw = *(const u32x4*)(P + krow * INWP + 512 + kvh * 64 + seg * 8);
            vraw = *(const u32x4*)(nloc ? (VTL + vrow * SEQ + nkt * 64 + seg * 8) : (VTC + vrow * CTXL + nkt * 64 + seg * 8));
        }
        const bool domask = local && (kt < 2 * qb || kt > 2 * qb + 1);
#pragma unroll 1
        for (int kh = 0; kh < 2; ++kh) {
            f32x4 s[2][4];
#pragma unroll
            for (int m = 0; m < 2; ++m)
#pragma unroll
                for (int n = 0; n < 4; ++n) s[m][n] = (f32x4){0.f, 0.f, 0.f, 0.f};
#pragma unroll
            for (int ks = 0; ks < 2; ++ks) {
                bf16x8 qf[4];
#pragma unroll
                for (int n = 0; n < 4; ++n) qf[n] = *(const bf16x8*)(Qw + n * 16 * 72 + ks * 32);
#pragma unroll
                for (int m = 0; m < 2; ++m) {
                    const bf16x8 kf = *(const bf16x8*)(Ks + ((kh * 2 + m) * 16 + fr) * 72 + ks * 32 + fq * 8);
#pragma unroll
                    for (int n = 0; n < 4; ++n) s[m][n] = mfma16(kf, qf[n], s[m][n]);
                }
            }
            if (domask) {
#pragma unroll
                for (int m = 0; m < 2; ++m)
#pragma unroll
                    for (int n = 0; n < 4; ++n)
#pragma unroll
                        for (int j = 0; j < 4; ++j) {
                            const int kpos = kt * 64 + (kh * 2 + m) * 16 + fq * 4 + j, qpos = qb * 128 + half * 64 + n * 16 + fr;
                            const int df = qpos - kpos;
                            if (df > 128 || df < -128) s[m][n][j] = -1e30f;
                        }
            }
#pragma unroll
            for (int n = 0; n < 4; ++n) {
                float mx = -1e30f;
#pragma unroll
                for (int m = 0; m < 2; ++m)
#pragma unroll
                    for (int j = 0; j < 4; ++j) mx = fmaxf(mx, s[m][n][j]);
                if (__builtin_amdgcn_ballot_w64(mx > mrun[n] + 8.f) != 0ull) {
                    mx = red_max_16_32(mx);
                    const float mnew = fmaxf(mrun[n], mx);
                    const float alpha = __builtin_amdgcn_exp2f(mrun[n] - mnew);
                    lrun[n] *= alpha; mrun[n] = mnew;
#pragma unroll
                    for (int dt = 0; dt < 4; ++dt) o[dt][n] = o[dt][n] * alpha;
                }
                const float mref = mrun[n];
                float rs = 0.f;
#pragma unroll
                for (int m = 0; m < 2; ++m)
#pragma unroll
                    for (int j = 0; j < 4; ++j) { const float pv = __builtin_amdgcn_exp2f(s[m][n][j] - mref); s[m][n][j] = pv; rs += pv; }
                lrun[n] += rs;
            }
            {
                bf16x8 pb[4];
#pragma unroll
                for (int n = 0; n < 4; ++n) {
                    u32x4 u; u.x = pk2(s[0][n][0], s[0][n][1]); u.y = pk2(s[0][n][2], s[0][n][3]); u.z = pk2(s[1][n][0], s[1][n][1]); u.w = pk2(s[1][n][2], s[1][n][3]);
                    pb[n] = __builtin_bit_cast(bf16x8, u);
                }
#pragma unroll
                for (int dt = 0; dt < 4; ++dt) {
                    const bf16x4 v0 = *(const bf16x4*)(Vs + (dt * 16 + fr) * 72 + (2 * kh) * 16 + fq * 4);
                    const bf16x4 v1 = *(const bf16x4*)(Vs + (dt * 16 + fr) * 72 + (2 * kh + 1) * 16 + fq * 4);
                    const bf16x8 va = __builtin_shufflevector(v0, v1, 0, 1, 2, 3, 4, 5, 6, 7);
#pragma unroll
                    for (int n = 0; n < 4; ++n) o[dt][n] = mfma16(va, pb[n], o[dt][n]);
                }
            }
        }
        if (more) {
            __syncthreads();
            stage_norm_rope(kraw, key, seg, kgn, nloc, nkt * 64 + key, ropel, 1.f, Ks);
            *(u32x4*)(Vs + key * 72 + seg * 8) = vraw;
            __syncthreads();
        }
    }
#pragma unroll
    for (int n = 0; n < 4; ++n) {
        const float inv = 1.f / red_sum_16_32(lrun[n]);
        const size_t row = (size_t)qrow0 + half * 64 + n * 16 + fr;
#pragma unroll
        for (int dt = 0; dt < 4; ++dt) {
            const f32x4 v = o[dt][n] * inv;
            u32x2 u; u.x = pk2(v.x, v.y); u.y = pk2(v.z, v.w);
            *(u32x2*)(MIX + row * DM + (kvh * 4 + g) * 64 + dt * 16 + fq * 4) = u;
        }
    }
}

DEVI void f1_load(const Params& p, int item, u32x4& a, u32x4& c2) {
    const int t = tidx(), g = item & 3, n2 = (item >> 2) & 63, b = item >> 8, n1 = t >> 2, cs = (t & 3) * 16;
    const bf16_t* src = (const bf16_t*)(p.ws + WS_P) + (size_t)(b * SEQ + 64 * n1 + n2) * INWP + 768 + g * 64 + cs;
    a = *(const u32x4*)src; c2 = *(const u32x4*)(src + 8);
}
DEVI void f1_item(const Params& p, int item, unsigned char* lds, u32x4& a, u32x4& c2, int next) {
    const int t = tidx(), lane = t & 63, w = t >> 6, fr = lane & 15, fq = lane >> 4;
    const int g = item & 3, n2 = (item >> 2) & 63, b = item >> 8;
    const bf16_t* D128 = (const bf16_t*)(p.ws + WS_D128);
    bf16_t* YP = (bf16_t*)(p.ws + WS_YP);
    bf16_t* uT = (bf16_t*)lds;
    __syncthreads();
    {
        const int n1 = t >> 2, cs = (t & 3) * 16;
        const unsigned uu[8] = {a.x, a.y, a.z, a.w, c2.x, c2.y, c2.z, c2.w};
        if (next >= 0) f1_load(p, next, a, c2);
#pragma unroll
        for (int i = 0; i < 8; ++i) { uT[(cs + 2 * i) * 136 + n1] = (bf16_t)(uu[i] & 0xffffu); uT[(cs + 2 * i + 1) * 136 + n1] = (bf16_t)(uu[i] >> 16); }
    }
    __syncthreads();
    f32x4 ar[4], ai[4];
#pragma unroll
    for (int n = 0; n < 4; ++n) { ar[n] = (f32x4){0.f, 0.f, 0.f, 0.f}; ai[n] = (f32x4){0.f, 0.f, 0.f, 0.f}; }
#pragma unroll
    for (int ks = 0; ks < 4; ++ks) {
        const bf16x8 a0 = *(const bf16x8*)(D128 + ((2 * w) * 16 + fr) * 128 + ks * 32 + fq * 8);
        const bf16x8 a1 = *(const bf16x8*)(D128 + ((2 * w + 1) * 16 + fr) * 128 + ks * 32 + fq * 8);
#pragma unroll
        for (int n = 0; n < 4; ++n) {
            const bf16x8 bb = *(const bf16x8*)(uT + (n * 16 + fr) * 136 + ks * 32 + fq * 8);
            ar[n] = mfma16(a0, bb, ar[n]); ai[n] = mfma16(a1, bb, ai[n]);
        }
    }
#pragma unroll
    for (int j = 0; j < 4; ++j) {
        const int k1 = 16 * w + fq * 4 + j;
        const float a = (float)(n2 * k1) * (1.f / 8192.f);
        const float tc = __builtin_amdgcn_cosf(a), ts = __builtin_amdgcn_sinf(a);
#pragma unroll
        for (int n = 0; n < 4; ++n) {
            const int c = n * 16 + fr;
            const float yr = ar[n][j], yi = ai[n][j];
            const float pr = yr * tc + yi * ts, pi = yi * tc - yr * ts;
            const size_t base = ((size_t)((b * 4 + g) * 128 + k1) * 2) * 4096 + n2 * 64 + c;
            YP[base] = f2bf(pr); YP[base + 4096] = f2bf(pi);
        }
    }
}

DEVI void f2_load(const Params& p, int item, bool cx, u32x4& a, u32x4& c2) {
    const int t = tidx(), rowi = t >> 2, cs = (t & 3) * 16;
    const int k1 = cx ? (item & 3) : (item & 127), g = cx ? ((item >> 2) & 3) : ((item >> 7) & 3), b = cx ? (item >> 4) : (item >> 9);
    const bf16_t* src = (const bf16_t*)(p.ws + (cx ? WS_YPC : WS_YP)) + ((size_t)((b * 4 + g) * (cx ? 4 : 128) + k1) * 128 + rowi) * 64 + cs;
    a = *(const u32x4*)src; c2 = *(const u32x4*)(src + 8);
}
DEVI void f2_item(const Params& p, int l, int item, unsigned char* lds, const bool cx, u32x4& a, u32x4& c2, int next, bool nextcx) {
    const int t = tidx(), lane = t & 63, w = t >> 6, fr = lane & 15, fq = lane >> 4;
    const int k1 = cx ? (item & 3) : (item & 127), g = cx ? ((item >> 2) & 3) : ((item >> 7) & 3), b = cx ? (item >> 4) : (item >> 9);
    const bf16_t* T64 = (const bf16_t*)(p.ws + WS_T64);
    const bf16_t* MMT = (const bf16_t*)(p.ws + WS_MMT) + (size_t)(l * 4 + g) * 8192;
    bf16_t* MIX = (bf16_t*)(p.ws + WS_MIX);
    bf16_t* Bt = (bf16_t*)lds;
    bf16_t* XX = Bt + 64 * 136;
    __syncthreads();
    {
        const int rowi = t >> 2, cs = (t & 3) * 16;
        const unsigned uu[8] = {a.x, a.y, a.z, a.w, c2.x, c2.y, c2.z, c2.w};
        if (next >= 0) f2_load(p, next, nextcx, a, c2);
#pragma unroll
        for (int i = 0; i < 8; ++i) { Bt[(cs + 2 * i) * 136 + rowi] = (bf16_t)(uu[i] & 0xffffu); Bt[(cs + 2 * i + 1) * 136 + rowi] = (bf16_t)(uu[i] >> 16); }
    }
    __syncthreads();
    f32x4 acc[4];
#pragma unroll
    for (int n = 0; n < 4; ++n) acc[n] = (f32x4){0.f, 0.f, 0.f, 0.f};
#pragma unroll
    for (int ks = 0; ks < 4; ++ks) {
        const bf16x8 a = *(const bf16x8*)(T64 + (w * 16 + fr) * 128 + ks * 32 + fq * 8);
#pragma unroll
        for (int n = 0; n < 4; ++n) acc[n] = mfma16(a, *(const bf16x8*)(Bt + (n * 16 + fr) * 136 + ks * 32 + fq * 8), acc[n]);
    }
    {
        const int po = w & 1;
#pragma unroll
        for (int n = 0; n < 4; ++n)
#pragma unroll
            for (int j = 0; j < 4; ++j) { const int k2 = (w >> 1) * 16 + fq * 4 + j; XX[k2 * 136 + po * 64 + n * 16 + fr] = f2bf(acc[n][j]); }
    }
    __syncthreads();
    const int kt2 = w >> 1;
    f32x4 a2[2];
    a2[0] = (f32x4){0.f, 0.f, 0.f, 0.f}; a2[1] = (f32x4){0.f, 0.f, 0.f, 0.f};
#pragma unroll
    for (int ks = 0; ks < 4; ++ks) {
        const bf16x8 bx = *(const bf16x8*)(XX + (kt2 * 16 + fr) * 136 + ks * 32 + fq * 8);
#pragma unroll
        for (int ei = 0; ei < 2; ++ei) { const int et = (w & 1) * 2 + ei; a2[ei] = mfma16(*(const bf16x8*)(MMT + (et * 16 + fr) * 128 + ks * 32 + fq * 8), bx, a2[ei]); }
    }
#pragma unroll
    for (int ei = 0; ei < 2; ++ei) {
        const int et = (w & 1) * 2 + ei, k2 = kt2 * 16 + fr, e = et * 16 + fq * 4;
        const float sc = cx ? 5.656854249f : 1.f;
        u32x2 u; u.x = pk2(a2[ei].x * sc, a2[ei].y * sc); u.y = pk2(a2[ei].z * sc, a2[ei].w * sc);
        const size_t orow = cx ? (size_t)(TOKL + b * CTXL + k1 + 4 * k2) : (size_t)(b * SEQ + k1 + 128 * k2);
        *(u32x2*)(MIX + orow * DM + 512 + g * 64 + e) = u;
    }
}

DEVI void cf_item(const Params& p, int l, int item, unsigned char* lds) {
    const int t = tidx();
    const int g = item & 3, b = item >> 2;
    const bf16_t* P = (const bf16_t*)(p.ws + WS_P);
    bf16_t* YPC = (bf16_t*)(p.ws + WS_YPC);
    const int n2 = t >> 3, cg8 = (t & 7) * 8;
    float u[4][8];
#pragma unroll
    for (int n1 = 0; n1 < 4; ++n1) unpack8(*(const u32x4*)(P + (size_t)(TOKL + b * CTXL + 64 * n1 + n2) * INWP + 768 + g * 64 + cg8), u[n1]);
#pragma unroll
    for (int k1 = 0; k1 < 4; ++k1) {
        const float a = (float)(n2 * k1) * (1.f / 256.f); const float tc = __builtin_amdgcn_cosf(a), ts = __builtin_amdgcn_sinf(a);
        float pr[8], pi[8];
#pragma unroll
        for (int i = 0; i < 8; ++i) {
            float yr, yi;
            if (k1 == 0) { yr = (u[0][i] + u[2][i]) + (u[1][i] + u[3][i]); yi = 0.f; }
            else if (k1 == 1) { yr = u[0][i] - u[2][i]; yi = u[3][i] - u[1][i]; }
            else if (k1 == 2) { yr = (u[0][i] + u[2][i]) - (u[1][i] + u[3][i]); yi = 0.f; }
            else { yr = u[0][i] - u[2][i]; yi = u[1][i] - u[3][i]; }
            pr[i] = yr * tc + yi * ts; pi[i] = yi * tc - yr * ts;
        }
        bf16_t* dst = YPC + ((size_t)(((b * 4 + g) * 4 + k1) * 2)) * 4096 + n2 * 64 + cg8;
        *(u32x4*)dst = pack8(pr); *(u32x4*)(dst + 4096) = pack8(pi);
    }
}

DEVI void gla_gates16(const Params& p, int l, int row0, int h, float* gzs, float (&v)[16]) {
    const int t = tidx();
    const bf16_t* P = (const bf16_t*)(p.ws + WS_P);
    float w[16]; float bias;
    {
        const int d = t & 63, dir = (t >> 6) & 1;
        const float* wg = (dir ? p.wgb : p.wgf) + (size_t)l * 16 * 256 + h * 64 + d;
        bias = (dir ? p.bgb : p.bgf)[l * 256 + h * 64 + d];
#pragma unroll
        for (int r = 0; r < 16; ++r) w[r] = wg[r * 256];
    }
    {
        const int tok = t >> 3, sg = (t & 7) * 4;
        const u32x2 u = *(const u32x2*)(P + (size_t)(row0 + tok) * INWP + 2048 + sg);
        gzs[tok * 32 + sg + 0] = bflo(u.x); gzs[tok * 32 + sg + 1] = bfhi(u.x); gzs[tok * 32 + sg + 2] = bflo(u.y); gzs[tok * 32 + sg + 3] = bfhi(u.y);
    }
    __syncthreads();
    {
        const int dir = (t >> 6) & 1, tq = t >> 7;
#pragma unroll
        for (int i = 0; i < 16; ++i) {
            const int tok = tq * 16 + i;
            typedef float f32x2_t __attribute__((ext_vector_type(2)));
            f32x2_t z2 = {bias, 0.f};
#pragma unroll
            for (int r = 0; r < 16; r += 2) z2 += (f32x2_t){gzs[tok * 32 + dir * 16 + r], gzs[tok * 32 + dir * 16 + r + 1]} * (f32x2_t){w[r], w[r + 1]};
            const float z = z2.x + z2.y;
            const float ls = fminf(z, 0.f) - __logf(1.f + __expf(-fabsf(z)));
            v[i] = ls * (1.f / 16.f);
        }
    }
    __syncthreads();
}
DEVI void gla_scan16(float (&v)[16], float* la, float* gzs) {
    const int t = tidx();
    const int d = t & 63, dir = (t >> 6) & 1, q = t >> 7;
    float* col = la + (dir * 64) * 64 + d;
    if (dir == 0) {
#pragma unroll
        for (int i = 1; i < 16; ++i) v[i] += v[i - 1];
        gzs[(q * 2 + dir) * 64 + d] = v[15];
    } else {
#pragma unroll
        for (int i = 14; i >= 0; --i) v[i] += v[i + 1];
        gzs[(q * 2 + dir) * 64 + d] = v[0];
    }
    __syncthreads();
    float off = 0.f;
#pragma unroll
    for (int qq = 0; qq < 4; ++qq) { const float tv = gzs[(qq * 2 + dir) * 64 + d]; if (dir == 0 ? (qq < q) : (qq > q)) off += tv; }
#pragma unroll
    for (int i = 0; i < 16; ++i) col[(q * 16 + i) * 64] = v[i] + off;
    __syncthreads();
}
DEVI int gla_row0(int b, int mc) { return mc < 4 ? (TOKL + b * CTXL + mc * 64) : (b * SEQ + (mc - 4) * 64); }
DEVI int gla_ci(int dir, int mc) { return dir == 0 ? mc : (mc < 4 ? 3 - mc : 135 - mc); }

DEVI void g1_item(const Params& p, int l, int item, unsigned char* lds) {
    const int t = tidx(), lane = t & 63, w = t >> 6, fr = lane & 15, fq = lane >> 4;
    const int h = item & 3, mc = (item >> 2) % NCI, b = (item >> 2) / NCI;
    const int row0 = gla_row0(b, mc);
    const bf16_t* P = (const bf16_t*)(p.ws + WS_P);
    bf16_t* UT = (bf16_t*)(p.ws + WS_UT);
    float* DEC = (float*)(p.ws + WS_DEC);
    float* la = (float*)lds;
    bf16_t* kT = (bf16_t*)(lds + 32768);
    bf16_t* vT = kT + 2 * 64 * 72;
    float* gzs = (float*)(lds + 32768 + 3 * 64 * 72 * 2);
    const u32x4 kraw = *(const u32x4*)(P + (size_t)(row0 + (t >> 3)) * INWP + 1280 + h * 64 + (t & 7) * 8);
    const u32x4 vraw = *(const u32x4*)(P + (size_t)(row0 + (t >> 3)) * INWP + 1536 + h * 64 + (t & 7) * 8);
    __syncthreads();
    {
        float lv[16];
        gla_gates16(p, l, row0, h, gzs, lv);
        bf16_t* LA = (bf16_t*)(p.ws + WS_LA) + (size_t)item * 8192 + (((t >> 6) & 1) * 64 + (t >> 7) * 16) * 64 + (t & 63);
#pragma unroll
        for (int i2 = 0; i2 < 16; ++i2) LA[i2 * 64] = f2bf(lv[i2]);
        gla_scan16(lv, la, gzs);
    }
    {
        const int s = t >> 3, seg = (t & 7) * 8;
        float kv[8], vv[8];
        unpack8(kraw, kv);
        unpack8(vraw, vv);
#pragma unroll
        for (int i = 0; i < 8; ++i) {
            const int d = seg + i;
            const float bt0 = la[63 * 64 + d], bt1 = la[64 * 64 + d];
            kT[(d) * 72 + s] = f2bf(kv[i] * __expf(bt0 - la[s * 64 + d]));
            kT[(64 + d) * 72 + s] = f2bf(kv[i] * __expf(bt1 - la[(64 + s) * 64 + d]));
            vT[d * 72 + s] = raw16(vraw, i);
        }
        if (t < 128) { const int dir = t >> 6, d = t & 63; const float bt = dir ? la[64 * 64 + d] : la[63 * 64 + d];
            DEC[((size_t)((b * 2 + dir) * NCI + gla_ci(dir, mc)) * 4 + h) * 64 + d] = __expf(bt); }
    }
    __syncthreads();
    {
        const int dir = w >> 2, mt = w & 3;
        f32x4 acc[4];
#pragma unroll
        for (int n = 0; n < 4; ++n) acc[n] = (f32x4){0.f, 0.f, 0.f, 0.f};
#pragma unroll
        for (int ks = 0; ks < 2; ++ks) {
            const bf16x8 a = *(const bf16x8*)(kT + (dir * 64 + mt * 16 + fr) * 72 + ks * 32 + fq * 8);
#pragma unroll
            for (int n = 0; n < 4; ++n) acc[n] = mfma16(a, *(const bf16x8*)(vT + (n * 16 + fr) * 72 + ks * 32 + fq * 8), acc[n]);
        }
        bf16_t* dst = UT + ((size_t)((b * 2 + dir) * NCI + gla_ci(dir, mc)) * 4 + h) * 4096;
#pragma unroll
        for (int n = 0; n < 4; ++n) { u32x2 u; u.x = pk2(acc[n].x, acc[n].y); u.y = pk2(acc[n].z, acc[n].w); *(u32x2*)(dst + (n * 16 + fr) * 64 + mt * 16 + fq * 4) = u; }
    }
}

DEVI void g2_item(const Params& p, int item) {
    const int gid = item * NT + tidx();
    const int d = gid & 63, e = (gid >> 6) & 63, h = (gid >> 12) & 3, bd = gid >> 14;
    bf16_t* u = (bf16_t*)(p.ws + WS_UT) + ((size_t)bd * NCI * 4 + h) * 4096 + e * 64 + d;
    const float* dc = (const float*)(p.ws + WS_DEC) + ((size_t)bd * NCI * 4 + h) * 64 + d;
    float s = 0.f;
    for (int c0 = 0; c0 < NCI; c0 += 33) {
        float uv[33], dv[33];
#pragma unroll
        for (int i = 0; i < 33; ++i) { uv[i] = bf2f(u[(size_t)(c0 + i) * 4 * 4096]); dv[i] = dc[(size_t)(c0 + i) * 256]; }
#pragma unroll
        for (int i = 0; i < 33; ++i) { u[(size_t)(c0 + i) * 4 * 4096] = f2bf(s); s = dv[i] * s + uv[i]; }
    }
}

struct G3Pre { u32x4 q, k, v, r; bf16_t la[16]; };
DEVI void g3_load(const Params& p, int item, G3Pre& d) {
    const int t = tidx();
    const int h = item & 3, mc = (item >> 2) % NCI, b = (item >> 2) / NCI;
    const int row0 = mc < 4 ? (TOKL + b * CTXL + mc * 64) : (b * SEQ + (mc - 4) * 64);
    const bf16_t* prow = (const bf16_t*)(p.ws + WS_P) + (size_t)(row0 + (t >> 3)) * INWP + h * 64 + (t & 7) * 8;
    d.q = *(const u32x4*)(prow + 1024); d.k = *(const u32x4*)(prow + 1280); d.v = *(const u32x4*)(prow + 1536); d.r = *(const u32x4*)(prow + 1792);
    const bf16_t* LA = (const bf16_t*)(p.ws + WS_LA) + (size_t)item * 8192 + (((t >> 6) & 1) * 64 + (t >> 7) * 16) * 64 + (t & 63);
#pragma unroll
    for (int i2 = 0; i2 < 16; ++i2) d.la[i2] = LA[i2 * 64];
}
DEVI void g3_item(const Params& p, int l, int item, unsigned char* lds, G3Pre& pre, int next) {
    const int t = tidx(), lane = t & 63, w = t >> 6, fr = lane & 15, fq = lane >> 4;
    const int h = item & 3, mc = (item >> 2) % NCI, b = (item >> 2) / NCI;
    const int row0 = gla_row0(b, mc);
    const bf16_t* P = (const bf16_t*)(p.ws + WS_P);
    const bf16_t* ST = (const bf16_t*)(p.ws + WS_UT);
    bf16_t* MIX = (bf16_t*)(p.ws + WS_MIX);
    float* la = (float*)lds;
    bf16_t* qi = (bf16_t*)(lds + 32768);
    bf16_t* ki = (bf16_t*)(lds + 51200);
    bf16_t* vT = (bf16_t*)(lds + 69632);
    bf16_t* sT = (bf16_t*)(lds + 78848);
    float* gzs = (float*)(lds + 97280);
    float* O = (float*)(lds + 105472);
    const u32x4 qraw = pre.q, kraw = pre.k, vraw = pre.v, rraw = pre.r;
    float lv[16];
#pragma unroll
    for (int i2 = 0; i2 < 16; ++i2) lv[i2] = bf2f(pre.la[i2]);
    if (next >= 0) g3_load(p, next, pre);
    __syncthreads();
    gla_scan16(lv, la, gzs);
    {
        const int s = t >> 3, seg = (t & 7) * 8;
        float qv[8], kv[8], vv[8];
        unpack8(qraw, qv);
        unpack8(kraw, kv);
        unpack8(vraw, vv);
#pragma unroll
        for (int dir = 0; dir < 2; ++dir) {
            float a[8], c[8];
#pragma unroll
            for (int i = 0; i < 8; ++i) { const float bc = la[(dir * 64 + s) * 64 + seg + i]; a[i] = qv[i] * 0.125f * __expf(bc); c[i] = kv[i] * __expf(-bc); }
            *(u32x4*)(qi + (dir * 64 + s) * 72 + seg) = pack8(a);
            *(u32x4*)(ki + (dir * 64 + s) * 72 + seg) = pack8(c);
        }
#pragma unroll
        for (int i = 0; i < 8; ++i) vT[(seg + i) * 72 + s] = raw16(vraw, i);
#pragma unroll
        for (int i = 0; i < 2; ++i) {
            const int id = i * NT + t, dir = id >> 9, e = (id >> 3) & 63, sg = (id & 7) * 8;
            const bf16_t* src = ST + ((size_t)((b * 2 + dir) * NCI + gla_ci(dir, mc)) * 4 + h) * 4096 + e * 64 + sg;
            *(u32x4*)(sT + (dir * 64 + e) * 72 + sg) = *(const u32x4*)src;
        }
    }
    __syncthreads();
    {
        const int dir = w >> 2, nt = w & 3;
        bf16x8 bq[2];
#pragma unroll
        for (int ks = 0; ks < 2; ++ks) bq[ks] = *(const bf16x8*)(qi + (dir * 64 + nt * 16 + fr) * 72 + ks * 32 + fq * 8);
        f32x4 sa[4];
#pragma unroll
        for (int m = 0; m < 4; ++m) sa[m] = (f32x4){0.f, 0.f, 0.f, 0.f};
#pragma unroll
        for (int ks = 0; ks < 2; ++ks)
#pragma unroll
            for (int m = 0; m < 4; ++m) sa[m] = mfma16(*(const bf16x8*)(ki + (dir * 64 + m * 16 + fr) * 72 + ks * 32 + fq * 8), bq[ks], sa[m]);
        const int tt = nt * 16 + fr;
#pragma unroll
        for (int m = 0; m < 4; ++m)
#pragma unroll
            for (int j = 0; j < 4; ++j) { const int s = m * 16 + fq * 4 + j; const bool keep = dir ? (s >= tt) : (s <= tt); if (!keep) sa[m][j] = 0.f; }
        f32x4 oa[4];
#pragma unroll
        for (int et = 0; et < 4; ++et) oa[et] = (f32x4){0.f, 0.f, 0.f, 0.f};
#pragma unroll
        for (int k2 = 0; k2 < 2; ++k2) {
            u32x4 u; u.x = pk2(sa[2 * k2][0], sa[2 * k2][1]); u.y = pk2(sa[2 * k2][2], sa[2 * k2][3]); u.z = pk2(sa[2 * k2 + 1][0], sa[2 * k2 + 1][1]); u.w = pk2(sa[2 * k2 + 1][2], sa[2 * k2 + 1][3]);
            const bf16x8 pb = __builtin_bit_cast(bf16x8, u);
#pragma unroll
            for (int et = 0; et < 4; ++et) {
                const bf16x4 v0 = *(const bf16x4*)(vT + (et * 16 + fr) * 72 + (2 * k2) * 16 + fq * 4);
                const bf16x4 v1 = *(const bf16x4*)(vT + (et * 16 + fr) * 72 + (2 * k2 + 1) * 16 + fq * 4);
                oa[et] = mfma16(__builtin_shufflevector(v0, v1, 0, 1, 2, 3, 4, 5, 6, 7), pb, oa[et]);
            }
        }
#pragma unroll
        for (int ks = 0; ks < 2; ++ks)
#pragma unroll
            for (int et = 0; et < 4; ++et) oa[et] = mfma16(*(const bf16x8*)(sT + (dir * 64 + et * 16 + fr) * 72 + ks * 32 + fq * 8), bq[ks], oa[et]);
#pragma unroll
        for (int et = 0; et < 4; ++et)
            *(f32x4*)(O + (dir * 64 + tt) * 68 + et * 16 + fq * 4) = oa[et];
    }
    __syncthreads();
    {
        const int tok = t >> 3, seg = (t & 7) * 8;
        float ov[8], rv[8]; float ss = 0.f;
        { const f32x4 a0 = *(const f32x4*)(O + tok * 68 + seg), a1 = *(const f32x4*)(O + tok * 68 + seg + 4), b0 = *(const f32x4*)(O + (64 + tok) * 68 + seg), b1 = *(const f32x4*)(O + (64 + tok) * 68 + seg + 4);
          const f32x4 s0 = a0 + b0, s1 = a1 + b1; ov[0] = s0.x; ov[1] = s0.y; ov[2] = s0.z; ov[3] = s0.w; ov[4] = s1.x; ov[5] = s1.y; ov[6] = s1.z; ov[7] = s1.w; }
#pragma unroll
        for (int i = 0; i < 8; ++i) ss += ov[i] * ov[i];
        ss += dpp_xor1(ss); ss += dpp_xor2(ss); ss += __shfl_xor(ss, 4);
        const float rstd = rsqrtf(ss * (1.f / 64.f) + 1e-6f);
        unpack8(rraw, rv);
#pragma unroll
        for (int i = 0; i < 8; ++i) ov[i] = ov[i] * rstd * p.glag[l * 64 + seg + i] * silu_f(rv[i]);
        *(u32x4*)(MIX + (size_t)(row0 + tok) * DM + 768 + h * 64 + seg) = pack8(ov);
    }
}

constexpr int NPH = 19;
DEVI void run_phase(const Params& p, int ph, unsigned char* lds) {
    if (ph == 0) { prep_phase(p, lds); return; }
    const int l = (ph - 1) / 9, s = (ph - 1) % 9;
    const bool last = (l == 1);
    const float* MOD = (const float*)(p.ws + WS_MOD) + l * 3 * 6144;
    bf16_t* H = (bf16_t*)(p.ws + WS_H);
    float* XC = (float*)(p.ws + WS_XC);
    switch (s) {
    case 0: norm_phase(p, l, 0); break;
    case 1: { EpiInProj e{(bf16_t*)(p.ws + WS_P), (bf16_t*)(p.ws + WS_VTL), (bf16_t*)(p.ws + WS_VTC)};
              gemm_phase8(H, (const bf16_t*)(p.ws + WS_WIN + l * SZ_WIN), DM, 66, 9, e, lds);
              {
                  const int G = gridDim.x, rem = (66 * 9) % G, first = rem ? rem : 0, nidle = G - first;
                  if ((int)blockIdx.x >= first) prep_phase(p, lds, l == 0 ? 1 : 2, first, nidle);
              } } break;
    case 2: {
        const int nA = last ? 256 : 264, nCF = last ? 0 : 8, nF1 = 512, nG1 = 2 * NCI * 4;
        const int G = gridDim.x;
        { const float* rt = (const float*)(p.ws + WS_ROPE); float* rl = (float*)(lds + ROPE_LDS_OFF); for (int i = tidx(); i < 4096; i += NT) rl[i] = rt[i]; }
        for (int it = blockIdx.x; it < nA; it += G) attn_item(p, l, it, lds);
        for (int it = (blockIdx.x + G - (nA % G)) % G; it < nCF; it += G) cf_item(p, l, it, lds);
        int g1s, g1n, gstep = 1, f1a = 0, f1n = 0, f1x = -1, fstep = 1;
        const int bx = blockIdx.x;
        if (G == 256) {
            if (!last) {
                if (bx < 8) { g1s = 3 * bx; g1n = 3; f1a = bx; f1n = 1; }
                else if (bx < 16) { g1s = 24 + 4 * (bx - 8); g1n = 4; f1a = bx; f1n = 1; }
                else if (bx < 56) { g1s = 56 + 5 * (bx - 16); g1n = 5; }
                else { g1s = 256 + 4 * (bx - 56); g1n = 4; f1a = 16 + 2 * (bx - 56); f1n = 2; if (bx < 152) f1x = 416 + (bx - 56); }
            } else {
                if (bx < 32) { g1s = 5 * bx; g1n = 5; }
                else { g1s = 160 + 4 * (bx - 32); g1n = 4; f1a = 2 * (bx - 32); f1n = 2; if (bx < 96) f1x = 448 + (bx - 32); }
            }
        } else {
            f1a = (bx + G - ((nA + nCF) % G)) % G; fstep = G; f1n = f1a < nF1 ? (nF1 - 1 - f1a) / G + 1 : 0;
            g1s = (bx + G - ((nA + nCF + nF1) % G)) % G; gstep = G; g1n = g1s < nG1 ? (nG1 - 1 - g1s) / G + 1 : 0;
        }
        {
            const int ftot = f1n + (f1x >= 0 ? 1 : 0);
            u32x4 fa, fc;
            if (ftot > 0) f1_load(p, f1a, fa, fc);
            for (int j = 0; j < ftot; ++j) {
                const int cur = j < f1n ? f1a + j * fstep : f1x;
                const int nxt = j + 1 < f1n ? f1a + (j + 1) * fstep : (j + 1 < ftot ? f1x : -1);
                f1_item(p, cur, lds, fa, fc, nxt);
            }
        }
        for (int j = 0; j < g1n; ++j) g1_item(p, l, g1s + j * gstep, lds);
    } break;
    case 3: {
        const int nG2 = 128, nF2 = 1024, nF2c = last ? 0 : 32;
        const int G = gridDim.x;
        for (int it = blockIdx.x; it < nG2; it += G) g2_item(p, it);
        if (G == 256) {
            const int bx = blockIdx.x;
            const int first = bx * 4, cnt = 4;
            const bool hasc = bx >= 128 && (bx - 128) < nF2c;
            u32x4 fa, fc; f2_load(p, first, false, fa, fc);
            for (int j = 0; j < cnt; ++j) { const bool lastj = j + 1 == cnt; f2_item(p, l, first + j, lds, false, fa, fc, lastj ? (hasc ? bx - 128 : -1) : first + j + 1, lastj && hasc); }
            if (hasc) f2_item(p, l, bx - 128, lds, true, fa, fc, -1, false);
        } else {
            u32x4 fa, fc;
            for (int it = blockIdx.x; it < nF2; it += G) { f2_load(p, it, false, fa, fc); f2_item(p, l, it, lds, false, fa, fc, -1, false); }
            for (int it = blockIdx.x; it < nF2c; it += G) { f2_load(p, it, true, fa, fc); f2_item(p, l, it, lds, true, fa, fc, -1, false); }
        }
    } break;
    case 4: {
        const int nG3 = 2 * NCI * 4;
        {
            const int G = gridDim.x;
            auto nxt = [&](int it) { for (it += G; it < nG3; it += G) { if (!(last && ((it >> 2) % NCI) < 4)) return it; } return -1; };
            int it = (int)blockIdx.x - G; it = nxt(it);
            G3Pre pre;
            if (it >= 0) g3_load(p, it, pre);
            while (it >= 0) { const int nx = nxt(it); g3_item(p, l, it, lds, pre, nx); it = nx; }
        }
    } break;
    case 5: { EpiResid e{l == 0 ? p.x : p.out, l == 0 ? p.ctx : XC, p.out, XC, MOD, 2 * DM, (float*)(p.ws + WS_PART)};
              gemm_phase8((const bf16_t*)(p.ws + WS_MIX), (const bf16_t*)(p.ws + WS_WOUT + l * SZ_WOUT), DM, 64, 4, e, lds, last ? 0 : 4); } break;
    case 6: norm_phase(p, l, 1); break;
    case 7: { EpiSwiglu e{(bf16_t*)(p.ws + WS_HID)};
              gemm_phase8(H, (const bf16_t*)(p.ws + WS_WFI + l * SZ_WFI), DM, last ? 64 : 66, 22, e, lds);
              if (l == 0) {
                  const int G = gridDim.x, rem = (66 * 22) % G, first = rem ? rem : 0, nidle = G - first;
                  if ((int)blockIdx.x >= first) prep_phase(p, lds, 4, first, nidle);
              } } break;
    case 8: { EpiResid e{p.out, XC, p.out, XC, MOD, 5 * DM, (float*)(p.ws + WS_PART)};
              gemm_phase8((const bf16_t*)(p.ws + WS_HID), (const bf16_t*)(p.ws + WS_WFO + l * SZ_WFO), FFH, 64, 4, e, lds, last ? 0 : 4); } break;
    }
}


#define XB_TMO      128
#define XB_XCNT(j)  (256  + 64 * (j))
#define XB_XSUB(j)  (1280 + 64 * (j))
#define XB_XGEN(j)  (2304 + 64 * (j))
#define XB_TOP      3328
#define XB_TOPGEN   3392
#define XCD_BAR_WORDS 3456
#define XB_SPIN_CAP (1u << 18)
DEVI unsigned xb_ld(unsigned* p) { return __hip_atomic_load(p, __ATOMIC_RELAXED, __HIP_MEMORY_SCOPE_AGENT); }
DEVI unsigned xb_add(unsigned* p, unsigned v) { return __hip_atomic_fetch_add(p, v, __ATOMIC_RELAXED, __HIP_MEMORY_SCOPE_AGENT); }
DEVI unsigned xb_xcc_id() { return (unsigned)__builtin_amdgcn_s_getreg((3 << 11) | 20) & 0xFu; }
#define XB_SPIN(cond, bar) do { unsigned _sp = 0; while (cond) { __builtin_amdgcn_s_sleep(1); \
    if ((++_sp & 255u) == 0u) { if (xb_ld(&(bar)[XB_TMO])) break; if (_sp > XB_SPIN_CAP) { atomicAdd(&(bar)[XB_TMO], 1u); break; } } } } while (0)
struct XcdBarrier { unsigned* bar; unsigned x; volatile __attribute__((address_space(3))) unsigned* st; };
DEVI XcdBarrier xcd_barrier_post(unsigned* bar, volatile __attribute__((address_space(3))) unsigned* st) {
    XcdBarrier b; b.bar = bar; b.x = xb_xcc_id(); b.st = st;
    if (threadIdx.x == 0) (void)xb_add(&bar[XB_XCNT(b.x)], 1u);
    return b;
}
DEVI void xcd_barrier_complete(unsigned* bar, unsigned x, unsigned& nloc, unsigned& nx) {
    const unsigned G = gridDim.x * gridDim.y * gridDim.z;
    unsigned sum, cnt, mine, sp = 0u;
    for (;;) {
        sum = 0u; cnt = 0u; mine = 0u;
#pragma unroll
        for (unsigned j = 0; j < 16; ++j) { const unsigned c = xb_ld(&bar[XB_XCNT(j)]); sum += c; cnt += (c > 0u) ? 1u : 0u; mine = (j == x) ? c : mine; }
        if (sum == G) break;
        __builtin_amdgcn_s_sleep(1);
        if ((++sp & 255u) == 0u) { if (xb_ld(&bar[XB_TMO])) break; if (sp > XB_SPIN_CAP) { atomicAdd(&bar[XB_TMO], 1u); break; } }
    }
    nloc = mine > 0u ? mine : 1u; nx = cnt > 0u ? cnt : 1u;
}
DEVI void xcd_barrier(const XcdBarrier& b) {
    asm volatile("s_waitcnt vmcnt(0)" ::: "memory");
    __syncthreads();
    if (threadIdx.x == 0) {
        unsigned* bar = b.bar;
        __builtin_amdgcn_s_waitcnt(0);
        unsigned nloc = b.st[0], nx = b.st[1];
        if (nloc == 0u) { xcd_barrier_complete(bar, b.x, nloc, nx); b.st[0] = nloc; b.st[1] = nx; }
        const unsigned old = xb_add(&bar[XB_XSUB(b.x)], 1u);
        const unsigned gen = old / nloc;
        if (old + 1u == (gen + 1u) * nloc) {
            __builtin_amdgcn_fence(__ATOMIC_RELEASE, "agent");
            asm volatile("s_waitcnt vmcnt(0)" ::: "memory");
            const unsigned og = xb_add(&bar[XB_TOP], 1u);
            const unsigned tg = og / nx;
            if (og + 1u == (tg + 1u) * nx) xb_add(&bar[XB_TOPGEN], 1u);
            else XB_SPIN(xb_ld(&bar[XB_TOPGEN]) == tg, bar);
            __builtin_amdgcn_fence(__ATOMIC_ACQUIRE, "agent");
            xb_add(&bar[XB_XGEN(b.x)], 1u);
            asm volatile("s_waitcnt vmcnt(0)" ::: "memory");
        } else {
            XB_SPIN(xb_ld(&bar[XB_XGEN(b.x)]) == gen, bar);
            __builtin_amdgcn_fence(__ATOMIC_ACQUIRE, "agent");
            asm volatile("s_waitcnt vmcnt(0)" ::: "memory");
        }
    }
    __syncthreads();
}

__global__ void __launch_bounds__(NT) mega_fwd(Params p) {
    extern __shared__ __attribute__((aligned(16))) unsigned char lds[];
    cg::grid_group grid = cg::this_grid();
    typedef const __attribute__((address_space(4))) Params* kparams_t;
    volatile __attribute__((address_space(3))) unsigned* xst = (volatile __attribute__((address_space(3))) unsigned*)((__attribute__((address_space(3))) unsigned char*)lds + (LDS_BYTES - 16));
    if (threadIdx.x == 0) { xst[0] = 0u; xst[1] = 0u; }
    __syncthreads();
    const bool fused = (p.ph_hi - p.ph_lo) > 1;
    XcdBarrier xb; xb.bar = (unsigned*)(p.ws + WS_BAR); xb.x = 0; xb.st = xst;
    if (fused) xb = xcd_barrier_post((unsigned*)(p.ws + WS_BAR), xst);
    for (int ph = p.ph_lo; ph < p.ph_hi; ++ph) {
        if (ph > p.ph_lo) { if (p.ph_lo < 0) grid.sync(); else xcd_barrier(xb); }
#if defined(__HIP_DEVICE_COMPILE__)
        kparams_t kp = (kparams_t)__builtin_amdgcn_kernarg_segment_ptr();
        asm volatile("" : "+s"(kp));
        Params lp;
        { const __attribute__((address_space(4))) unsigned long long* s8 = (const __attribute__((address_space(4))) unsigned long long*)kp; unsigned long long* d8 = (unsigned long long*)&lp;
#pragma unroll
          for (int i = 0; i < (int)(sizeof(Params) / 8); ++i) d8[i] = s8[i]; }
        run_phase(lp, ph, lds);
#endif
    }
}

extern "C" void kernel_launch(void* const* d_in, const int* in_sizes, int n_in, void* d_out, int out_size, void* d_ws, size_t ws_size, hipStream_t stream) {
    static int grid = 0;
    if (grid == 0) {
        if (ws_size < WS_TOTAL) { fprintf(stderr, "kernel_launch: workspace too small (%zu < %zu)\n", ws_size, (size_t)WS_TOTAL); grid = -1; return; }
        int dev = 0, cus = 0, per_cu = 0;
        hipGetDevice(&dev);
        hipDeviceGetAttribute(&cus, hipDeviceAttributeMultiprocessorCount, dev);
        if (hipFuncSetAttribute((const void*)mega_fwd, hipFuncAttributeMaxDynamicSharedMemorySize, LDS_BYTES) != hipSuccess) fprintf(stderr, "kernel_launch: hipFuncSetAttribute failed\n");
        if (hipOccupancyMaxActiveBlocksPerMultiprocessor(&per_cu, (const void*)mega_fwd, NT, LDS_BYTES) != hipSuccess || per_cu < 1) { fprintf(stderr, "kernel_launch: occupancy query gave %d\n", per_cu); per_cu = 1; }
        (void)hipGetLastError();
        grid = cus * per_cu;
        fprintf(stderr, "kernel_launch: grid %d (cus %d x %d)\n", grid, cus, per_cu);
    }
    if (grid < 0) return;
    (void)hipMemsetAsync((unsigned char*)d_ws + WS_BAR, 0, 16384, stream);
    Params p{};
    const float** f = (const float**)&p;
    for (int i = 0; i < 21; ++i) f[i] = (const float*)d_in[i];
    p.out = (float*)d_out; p.ws = (unsigned char*)d_ws;
#if N_LAUNCH_SPLIT
    for (int ph = 0; ph < NPH; ++ph) { p.ph_lo = ph; p.ph_hi = ph + 1; hipLaunchKernelGGL(mega_fwd, dim3(grid), dim3(NT), LDS_BYTES, stream, p); }
#else
    p.ph_lo = 0; p.ph_hi = NPH;
    void* args[] = {&p};
    hipError_t e = hipLaunchCooperativeKernel((const void*)mega_fwd, dim3(grid), dim3(NT), args, LDS_BYTES, stream);
    if (e != hipSuccess) fprintf(stderr, "kernel_launch: cooperative launch failed: %s (grid %d)\n", hipGetErrorString(e), grid);
#endif
}
```
